# Optimizing an MI355X kernel written in HIP

```python
import math
import jax, jax.numpy as jnp
from jax import lax
import numpy as np

D_MODEL = 1024
BATCH = 2
SEQ = 8192
DEPTH = 1

D_MIX = D_MODEL
SB_HEADS = 8
SB_HEAD_DIM = 64
SB_WIDTH = SB_HEADS * SB_HEAD_DIM
DF_HEADS = 4
DF_HEAD_DIM = 64
DF_V_DIM = 2 * DF_HEAD_DIM
DF_QK_WIDTH = DF_HEADS * 2 * DF_HEAD_DIM
DF_WIDTH = DF_HEADS * DF_V_DIM
IN_COLS = 4 * SB_WIDTH + 2 * DF_QK_WIDTH + 2 * DF_WIDTH
BLOCK_Q = 128
EPS = 1e-6

kernel_name = "hybrid_stickbreak_diffattn_adaln_block"


def _rmsnorm(x, g):
    xf = x.astype(jnp.float32)
    y = xf * lax.rsqrt(jnp.mean(xf * xf, axis=-1, keepdims=True) + EPS)
    return (y * g.astype(jnp.float32)).astype(x.dtype)


def _alibi_slopes(n_heads):
    return jnp.asarray([2.0 ** (-8.0 * (h + 1) / n_heads) for h in range(n_heads)], dtype=jnp.float32)


def _to_blocks(t, nb):
    b, hh, s, d = t.shape
    return t.reshape(b, hh, nb, BLOCK_Q, d).transpose(2, 0, 1, 3, 4)


def _from_blocks(o):
    nb, b, hh, q, d = o.shape
    return o.transpose(1, 0, 3, 2, 4).reshape(b, nb * q, hh * d)


def _stick_breaking(q, k, v):
    s_len = k.shape[2]
    nb = s_len // BLOCK_Q
    inv = 1.0 / math.sqrt(q.shape[-1])
    kf = k.astype(jnp.float32)
    vf = v.astype(jnp.float32)
    spos = jnp.arange(s_len, dtype=jnp.int32)

    def block(args):
        qb, t0 = args
        z = jnp.einsum('bhqd,bhkd->bhqk', qb.astype(jnp.float32), kf) * inv
        tpos = t0 + jnp.arange(BLOCK_Q, dtype=jnp.int32)
        mask = spos[None, :] < tpos[:, None]
        log_1m = jnp.where(mask, jax.nn.log_sigmoid(-z), 0.0)
        rem = lax.cumsum(log_1m, axis=3, reverse=True) - log_1m
        a = jnp.where(mask, jnp.exp(jax.nn.log_sigmoid(z) + rem), 0.0)
        return jnp.einsum('bhqk,bhkd->bhqd', a, vf)

    starts = jnp.arange(nb, dtype=jnp.int32) * BLOCK_Q
    o = lax.map(block, (_to_blocks(q, nb), starts))
    return _from_blocks(o)


def _diff_attention(q1, q2, k1, k2, v, lam, slopes):
    s_len = k1.shape[2]
    nb = s_len // BLOCK_Q
    inv = 1.0 / math.sqrt(q1.shape[-1])
    k1f = k1.astype(jnp.float32)
    k2f = k2.astype(jnp.float32)
    vf = v.astype(jnp.float32)
    spos = jnp.arange(s_len, dtype=jnp.int32)

    def block(args):
        qb1, qb2, t0 = args
        tpos = t0 + jnp.arange(BLOCK_Q, dtype=jnp.int32)
        dist = (tpos[:, None] - spos[None, :]).astype(jnp.float32)
        mask = dist >= 0.0
        bias = -slopes[:, None, None] * dist
        s1 = jnp.einsum('bhqd,bhkd->bhqk', qb1.astype(jnp.float32), k1f) * inv + bias
        s2 = jnp.einsum('bhqd,bhkd->bhqk', qb2.astype(jnp.float32), k2f) * inv + bias
        p1 = jax.nn.softmax(jnp.where(mask, s1, -jnp.inf), axis=-1)
        p2 = jax.nn.softmax(jnp.where(mask, s2, -jnp.inf), axis=-1)
        return jnp.einsum('bhqk,bhkd->bhqd', p1 - lam * p2, vf)

    starts = jnp.arange(nb, dtype=jnp.int32) * BLOCK_Q
    o = lax.map(block, (_to_blocks(q1, nb), _to_blocks(q2, nb), starts))
    return o


def _layer(x, c, layer_idx, norm_g, w_ada, b_ada, w_in, q_norm_g, k_norm_g,
           lambda_q1, lambda_k1, lambda_q2, lambda_k2, subln_g, w_out):
    b, s, _ = x.shape
    mod = (c @ w_ada + b_ada).astype(jnp.float32)
    shift, scale, gate = jnp.split(mod, 3, axis=-1)
    h = (_rmsnorm(x, norm_g).astype(jnp.float32) * (1.0 + scale[:, None, :]) + shift[:, None, :]).astype(x.dtype)

    proj = h @ w_in
    cuts = np.cumsum([SB_WIDTH, SB_WIDTH, SB_WIDTH, SB_WIDTH, DF_QK_WIDTH, DF_QK_WIDTH, DF_WIDTH])
    sb_q, sb_k, sb_v, sb_g, df_q, df_k, df_v, df_g = jnp.split(proj, [int(i) for i in cuts], axis=-1)

    def heads(t, nh, d):
        return t.reshape(b, s, nh, d).transpose(0, 2, 1, 3)
    sb_out = _stick_breaking(heads(sb_q, SB_HEADS, SB_HEAD_DIM),
                             heads(sb_k, SB_HEADS, SB_HEAD_DIM),
                             heads(sb_v, SB_HEADS, SB_HEAD_DIM))
    sb_out = sb_out * jax.nn.silu(sb_g.astype(jnp.float32))

    qd = _rmsnorm(df_q.reshape(b, s, DF_HEADS, 2, DF_HEAD_DIM), q_norm_g)
    kd = _rmsnorm(df_k.reshape(b, s, DF_HEADS, 2, DF_HEAD_DIM), k_norm_g)
    q1 = qd[:, :, :, 0].transpose(0, 2, 1, 3)
    q2 = qd[:, :, :, 1].transpose(0, 2, 1, 3)
    k1 = kd[:, :, :, 0].transpose(0, 2, 1, 3)
    k2 = kd[:, :, :, 1].transpose(0, 2, 1, 3)
    vd = heads(df_v, DF_HEADS, DF_V_DIM)
    lam_init = 0.8 - 0.6 * math.exp(-0.3 * layer_idx)
    lam = (jnp.exp(jnp.sum(lambda_q1.astype(jnp.float32) * lambda_k1.astype(jnp.float32)))
           - jnp.exp(jnp.sum(lambda_q2.astype(jnp.float32) * lambda_k2.astype(jnp.float32)))
           + lam_init)
    df_o = _diff_attention(q1, q2, k1, k2, vd, lam, _alibi_slopes(DF_HEADS))
    df_o = _rmsnorm(df_o, subln_g) * (1.0 - lam_init)
    df_out = _from_blocks(df_o) * jax.nn.silu(df_g.astype(jnp.float32))

    mixed = jnp.concatenate([sb_out, df_out], axis=-1).astype(x.dtype)
    out = (mixed @ w_out).astype(jnp.float32)
    return (x.astype(jnp.float32) + gate[:, None, :] * out).astype(x.dtype)


def setup_inputs(seed: int = 0) -> dict:
    key = jax.random.key(seed)
    ks = jax.random.split(key, 16)
    f32 = jnp.float32
    d = D_MODEL
    return {
        "x": jax.random.normal(ks[0], (BATCH, SEQ, d), f32),
        "c": jax.random.normal(ks[1], (BATCH, d), f32),
        "norm_g": 1.0 + 0.02 * jax.random.normal(ks[2], (DEPTH, d), f32),
        "w_ada": 0.5 * d ** -0.5 * jax.random.normal(ks[3], (DEPTH, d, 3 * d), f32),
        "b_ada": 0.01 * jax.random.normal(ks[4], (DEPTH, 3 * d), f32),
        "w_in": d ** -0.5 * jax.random.normal(ks[5], (DEPTH, d, IN_COLS), f32),
        "q_norm_g": 1.0 + 0.02 * jax.random.normal(ks[6], (DEPTH, DF_HEAD_DIM), f32),
        "k_norm_g": 1.0 + 0.02 * jax.random.normal(ks[7], (DEPTH, DF_HEAD_DIM), f32),
        "lambda_q1": 0.1 * jax.random.normal(ks[8], (DEPTH, DF_HEAD_DIM), f32),
        "lambda_k1": 0.1 * jax.random.normal(ks[9], (DEPTH, DF_HEAD_DIM), f32),
        "lambda_q2": 0.1 * jax.random.normal(ks[10], (DEPTH, DF_HEAD_DIM), f32),
        "lambda_k2": 0.1 * jax.random.normal(ks[11], (DEPTH, DF_HEAD_DIM), f32),
        "subln_g": 1.0 + 0.02 * jax.random.normal(ks[12], (DEPTH, DF_V_DIM), f32),
        "w_out": D_MIX ** -0.5 * jax.random.normal(ks[13], (DEPTH, D_MIX, d), f32),
    }


def reference(x, c, norm_g, w_ada, b_ada, w_in, q_norm_g, k_norm_g,
              lambda_q1, lambda_k1, lambda_q2, lambda_k2, subln_g, w_out):
    for l in range(DEPTH):
        x = _layer(x, c, l, norm_g[l], w_ada[l], b_ada[l], w_in[l], q_norm_g[l], k_norm_g[l],
                   lambda_q1[l], lambda_k1[l], lambda_q2[l], lambda_k2[l], subln_g[l], w_out[l])
    return x
```

```cpp
#include <hip/hip_runtime.h>
#include <hip/hip_cooperative_groups.h>
#include <cstdio>
#include <cstdint>
namespace cg = cooperative_groups;
namespace pg8 {
#define PG8_LAS __attribute__((address_space(3)))
typedef unsigned short bf16_t;
typedef short bf16x8 __attribute__((ext_vector_type(8)));
typedef float f32x4 __attribute__((ext_vector_type(4)));
typedef unsigned u32x4 __attribute__((ext_vector_type(4)));
constexpr int BM = 256, BK = 64, HALF = 128, HTB = HALF * BK * 2  , STAGE_BYTES = 8 * HTB, NXCD = 8, WGM = 8;

__host__ __device__ __forceinline__ int lds_byte(int r, int c) { const int st = (r >> 4) * 2 + (c >> 5), rr = r & 15, cc = c & 31, ob = rr * 64 + cc * 2; return st * 1024 + (ob ^ (((ob >> 9) & 1) << 5)); }
__host__ __device__ __forceinline__ void stage_rc(int b, int& R, int& C) { const int st = b / 1024, sb = b % 1024, swz = sb ^ (((sb >> 9) & 1) << 5); R = (st >> 1) * 16 + swz / 64; C = (st & 1) * 32 + (swz % 64) / 2; }
__host__ __device__ __forceinline__ int perm32(int rho) { const int n = rho >> 4, i = rho & 15; return 8 * (i >> 2) + 4 * n + (i & 3); }

struct Unit { int pm, pn; };
struct Gemm { const bf16_t* A; const bf16_t* Bt; int M, N, K; };

struct StaticOrder {
    int nM, nN, nwg, G, c;
    __host__ __device__ void init(int M, int N, int G_, int c_) { nM = M / BM; nN = N / BM; nwg = nM * nN; G = G_; c = c_; }
    __host__ __device__ bool next(int i, Unit& u) const {
        const long L = (long)i * G + c; if (L >= nwg) return false;
        int wgid = (int)L; { const int q = nwg / NXCD, r = nwg % NXCD, xcd = wgid % NXCD, off = wgid / NXCD; wgid = (xcd < r ? xcd * (q + 1) : r * (q + 1) + (xcd - r) * q) + off; }
        const int nig = WGM * nN, gid = wgid / nig, fm = gid * WGM, gsz = (nM - fm) < WGM ? (nM - fm) : WGM;
        u.pm = fm + ((wgid % nig) % gsz); u.pn = (wgid % nig) / gsz; return true;
    }
    __device__ __forceinline__ void a_ready(const Unit&) const {}
    __device__ __forceinline__ void done(const Unit&) const {}
};

__device__ __forceinline__ unsigned cvt_pk_bf16(float lo, float hi) { unsigned r; asm volatile("v_cvt_pk_bf16_f32 %0, %1, %2" : "=v"(r) : "v"(lo), "v"(hi)); return r; }
template <class Epi, class Sched, bool ALIGN_EPI = false, bool SP2 = false>
__device__ __forceinline__ void gemm_phase(PG8_LAS unsigned char* lds, const Gemm g, const Sched& S, const Epi& E) {
    int tid_ = threadIdx.x; asm volatile("" : "+v"(tid_));
    const int tid = tid_, wid = __builtin_amdgcn_readfirstlane(tid >> 6), lane = tid & 63, wr = wid >> 2, wc = wid & 3, fr = lane & 15, fq = lane >> 4;
    const int K = g.K, nt = K / BK;
    unsigned voffA[2], voffB[2];
#pragma unroll
    for (int i = 0; i < 2; ++i) { int R, C; stage_rc(tid * 16 + i * 8192, R, C); const int Rb = Epi::PERM ? ((R & ~31) + perm32(R & 31)) : R;
        voffA[i] = (unsigned)(R * K + C) * 2u; voffB[i] = (unsigned)(Rb * K + C) * 2u; }
    const size_t kstep = (size_t)(BK * 2);
    const size_t hstep = (size_t)HALF * K * 2;
    const size_t tstep = 2 * hstep;
    const unsigned ldsw = (unsigned)wid * 1024u;
    const int aoff = lds_byte(wr * 64 + fr, fq * 8), boff = lds_byte(wc * 32 + fr, fq * 8);
#define PG8_SA(b, h) (((b) * 2 + (h)) * HTB)
#define PG8_SB(b, h) ((4 + (b) * 2 + (h)) * HTB)
#define PG8_STAGE(bufoff, gbase, voff) do { _Pragma("unroll") for (int _i = 0; _i < 2; ++_i) \
        __builtin_amdgcn_global_load_lds((const unsigned*)((const char*)(gbase) + (voff)[_i]), (PG8_LAS unsigned*)(lds + (bufoff) + ldsw + _i * 8192), 16, 0, 0); } while (0)
#define PG8_LDA(dst, b, h) do { _Pragma("unroll") for (int m = 0; m < 4; ++m) _Pragma("unroll") for (int k = 0; k < 2; ++k) dst[m][k] = *(const PG8_LAS bf16x8*)(lds + PG8_SA(b, h) + aoff + m * 2048 + k * 1024); } while (0)
#define PG8_LDB(dst, b, h) do { _Pragma("unroll") for (int n = 0; n < 2; ++n) _Pragma("unroll") for (int k = 0; k < 2; ++k) dst[n][k] = *(const PG8_LAS bf16x8*)(lds + PG8_SB(b, h) + boff + n * 2048 + k * 1024); } while (0)
#define PG8_MMA(ai, bj, At, Bt) do { __builtin_amdgcn_s_setprio(1); _Pragma("unroll") for (int m = 0; m < 4; ++m) _Pragma("unroll") for (int n = 0; n < 2; ++n) _Pragma("unroll") for (int k = 0; k < 2; ++k) \
        acc[ai][bj][m][n] = __builtin_amdgcn_mfma_f32_16x16x32_bf16(Bt[n][k], At[m][k], acc[ai][bj][m][n], 0, 0, 0); __builtin_amdgcn_s_setprio(0); } while (0)
#define PG8_WAIT_V(n) asm volatile("s_waitcnt vmcnt(" #n ")" ::: "memory")
#define PG8_WAIT_L(n) asm volatile("s_waitcnt lgkmcnt(" #n ")" ::: "memory")
#define PG8_BAR __builtin_amdgcn_s_barrier()
#define PG8_SCHED __builtin_amdgcn_sched_barrier(0)
    Unit cur, nxt; int ui = 0;
    if (!S.next(0, cur)) return;
    f32x4 acc[2][2][4][2];
#pragma unroll
    for (int a = 0; a < 2; ++a)
#pragma unroll
        for (int b = 0; b < 2; ++b)
#pragma unroll
            for (int m = 0; m < 4; ++m)
#pragma unroll
                for (int n = 0; n < 2; ++n) acc[a][b][m][n] = (f32x4){0.f, 0.f, 0.f, 0.f};
    bf16x8 At[4][2], B0[2][2], B1[2][2];
    const char* cA = (const char*)g.A + (size_t)cur.pm * tstep; const char* cB = (const char*)g.Bt + (size_t)cur.pn * tstep;
    S.a_ready(cur);
    if constexpr (SP2) {
        PG8_STAGE(PG8_SB(0, 0), cB, voffB); PG8_STAGE(PG8_SB(0, 1), cB + hstep, voffB); PG8_STAGE(PG8_SA(0, 0), cA, voffA); PG8_STAGE(PG8_SA(0, 1), cA + hstep, voffA);
        if (wr == 1) PG8_BAR;
        PG8_WAIT_V(2); PG8_BAR;
        PG8_STAGE(PG8_SB(1, 0), cB + kstep, voffB); PG8_STAGE(PG8_SA(1, 0), cA + kstep, voffA); PG8_STAGE(PG8_SB(1, 1), cB + hstep + kstep, voffB);
        PG8_WAIT_V(6); PG8_BAR;
    } else {
        PG8_STAGE(PG8_SB(0, 0), cB, voffB); PG8_STAGE(PG8_SA(0, 0), cA, voffA); PG8_STAGE(PG8_SB(0, 1), cB + hstep, voffB); PG8_STAGE(PG8_SA(0, 1), cA + hstep, voffA);
        if (wr == 1) PG8_BAR;
        PG8_WAIT_V(4); PG8_BAR;
        PG8_STAGE(PG8_SB(1, 0), cB + kstep, voffB); PG8_STAGE(PG8_SA(1, 0), cA + kstep, voffA); PG8_STAGE(PG8_SB(1, 1), cB + hstep + kstep, voffB);
        PG8_WAIT_V(6); PG8_BAR;
    }
    for (;;) {
        const bool has_next = S.next(ui + 1, nxt);
        const char* nA = has_next ? (const char*)g.A + (size_t)nxt.pm * tstep : cA; const char* nB = has_next ? (const char*)g.Bt + (size_t)nxt.pn * tstep : cB;
        for (int t = 0; t < nt; t += 2) {
            const bool last = (t == nt - 2);
            const char* a1 = cA + (size_t)(t + 1) * kstep;
            const char* a2 = last ? nA : cA + (size_t)(t + 2) * kstep; const char* b2 = last ? nB : cB + (size_t)(t + 2) * kstep;
            const char* a3 = a2 + kstep; const char* b3 = b2 + kstep;
            if (last && has_next) S.a_ready(nxt);
            if constexpr (SP2) {
            PG8_LDB(B0, 0, 0); PG8_LDB(B1, 0, 1); PG8_SCHED; PG8_LDA(At, 0, 0); PG8_STAGE(PG8_SA(1, 1), a1 + hstep, voffA);
            PG8_WAIT_V(8); PG8_WAIT_L(0); PG8_BAR; PG8_MMA(0, 0, At, B0); PG8_MMA(0, 1, At, B1); PG8_BAR; PG8_SCHED;
            PG8_LDA(At, 0, 1); PG8_STAGE(PG8_SB(0, 0), b2, voffB); PG8_STAGE(PG8_SB(0, 1), b2 + hstep, voffB); PG8_STAGE(PG8_SA(0, 0), a2, voffA);
            PG8_WAIT_V(8); PG8_WAIT_L(0); PG8_BAR; PG8_MMA(1, 0, At, B0); PG8_MMA(1, 1, At, B1); PG8_BAR; PG8_SCHED;
            PG8_LDB(B0, 1, 0); PG8_LDB(B1, 1, 1); PG8_SCHED; PG8_LDA(At, 1, 0); PG8_STAGE(PG8_SA(0, 1), a2 + hstep, voffA);
            PG8_WAIT_V(8); PG8_WAIT_L(0); PG8_BAR; PG8_MMA(0, 0, At, B0); PG8_MMA(0, 1, At, B1); PG8_BAR; PG8_SCHED;
            PG8_LDA(At, 1, 1); PG8_STAGE(PG8_SB(1, 0), b3, voffB); PG8_STAGE(PG8_SB(1, 1), b3 + hstep, voffB); PG8_STAGE(PG8_SA(1, 0), a3, voffA);
            PG8_WAIT_V(8); PG8_WAIT_L(0); PG8_BAR; PG8_MMA(1, 0, At, B0); PG8_MMA(1, 1, At, B1); PG8_BAR; PG8_SCHED;
            } else {
            PG8_LDB(B0, 0, 0); PG8_SCHED; PG8_LDA(At, 0, 0); PG8_STAGE(PG8_SA(1, 1), a1 + hstep, voffA);
            PG8_WAIT_L(8); PG8_BAR; PG8_WAIT_L(0); PG8_MMA(0, 0, At, B0); PG8_BAR; PG8_SCHED;
            PG8_LDB(B1, 0, 1); PG8_STAGE(PG8_SB(0, 0), b2, voffB);
            PG8_BAR; PG8_WAIT_L(0); PG8_MMA(0, 1, At, B1); PG8_BAR;
            PG8_LDA(At, 0, 1); PG8_STAGE(PG8_SA(0, 0), a2, voffA);
            PG8_BAR; PG8_WAIT_L(0); PG8_MMA(1, 0, At, B0); PG8_BAR; PG8_SCHED;
            PG8_STAGE(PG8_SB(0, 1), b2 + hstep, voffB);
            PG8_WAIT_V(6); PG8_BAR; PG8_MMA(1, 1, At, B1); PG8_BAR;
            PG8_LDB(B0, 1, 0); PG8_SCHED; PG8_LDA(At, 1, 0); PG8_STAGE(PG8_SA(0, 1), a2 + hstep, voffA);
            PG8_WAIT_L(8); PG8_BAR; PG8_WAIT_L(0); PG8_MMA(0, 0, At, B0); PG8_BAR; PG8_SCHED;
            PG8_LDB(B1, 1, 1); PG8_STAGE(PG8_SB(1, 0), b3, voffB);
            PG8_BAR; PG8_WAIT_L(0); PG8_MMA(0, 1, At, B1); PG8_BAR;
            PG8_LDA(At, 1, 1); PG8_STAGE(PG8_SA(1, 0), a3, voffA);
            PG8_BAR; PG8_WAIT_L(0); PG8_MMA(1, 0, At, B0); PG8_BAR; PG8_SCHED;
            PG8_STAGE(PG8_SB(1, 1), b3 + hstep, voffB);
            PG8_WAIT_V(6); PG8_BAR; PG8_MMA(1, 1, At, B1); PG8_BAR;
            }
        }
        if constexpr (ALIGN_EPI) { if (wr == 0) PG8_BAR; }
        if constexpr (!Epi::AFTER_DRAIN) { E(acc, cur, wr, wc, fr, fq); S.done(cur); }
        if (!has_next) break;
#pragma unroll
        for (int a = 0; a < 2; ++a)
#pragma unroll
            for (int b = 0; b < 2; ++b)
#pragma unroll
                for (int m = 0; m < 4; ++m)
#pragma unroll
                    for (int n = 0; n < 2; ++n) acc[a][b][m][n] = (f32x4){0.f, 0.f, 0.f, 0.f};
        cur = nxt; cA = nA; cB = nB; ++ui;
        if constexpr (ALIGN_EPI) { if (wr == 1) PG8_BAR; }
    }
    PG8_WAIT_V(0);
    if constexpr (!ALIGN_EPI) { if (wr == 0) PG8_BAR; }
    PG8_BAR;
    if constexpr (Epi::AFTER_DRAIN) { E.fused(acc, cur, wr, wc, fr, fq, lds, wid, lane); S.done(cur); }
#undef PG8_SA
#undef PG8_SB
#undef PG8_STAGE
#undef PG8_LDA
#undef PG8_LDB
#undef PG8_MMA
#undef PG8_WAIT_V
#undef PG8_WAIT_L
#undef PG8_BAR
#undef PG8_SCHED
}
}

constexpr int BATCH = 2, SEQ = 8192, DM = 1024, MROWS = BATCH * SEQ, NIN = 4096;
constexpr float EPS = 1e-6f, LOG2E = 1.4426950408889634f, C2 = 0.125f * 1.4426950408889634f;
constexpr size_t MiB = 1u << 20;
constexpr size_t WS_MOD = 0, WS_WIN = 1 * MiB, WS_WOUT = 9 * MiB, WS_XN = 16 * MiB, WS_SBQ = 48 * MiB, WS_SBK = 64 * MiB, WS_SBG = 80 * MiB,
                 WS_DFQ = 96 * MiB, WS_DFK = 112 * MiB, WS_DFG = 128 * MiB, WS_SBVT = 144 * MiB, WS_DFVT = 160 * MiB, WS_MIX = 176 * MiB, WS_END = 208 * MiB;
constexpr int RING_BYTES = 131072, LDS_BYTES = 147456, MISC_OFF = RING_BYTES;
constexpr int SC_LAM = 6144, SC_MB = 6145;
constexpr size_t WS_BAR = 256 * 1024, BAR_ZERO_BYTES = 16384;
constexpr int BAR_QCTR = 3520;
constexpr int LDSCTL_OFF = MISC_OFF + 4096;
#define LAS __attribute__((address_space(3)))

namespace pg8 {
struct EpiIn {
    static constexpr bool PERM = true, AFTER_DRAIN = false;
    bf16_t *SBQ, *SBK, *SBG, *DFQ, *DFK, *DFG, *SBVT, *DFVT; const float *qg, *kg;
    __device__ __forceinline__ void operator()(const f32x4 (&acc)[2][2][4][2], const Unit& u, int wr, int wc, int fr, int fq) const {
        const int kind = u.pn >> 1;
        const int row0 = u.pm * BM + wr * 64 + fr;
        const int cl = (u.pn & 1) * 256 + wc * 64 + 8 * fq;
        if (kind == 2 || kind == 6) {
            bf16_t* VT = (kind == 2) ? SBVT : DFVT; const int dsh = (kind == 2) ? 6 : 7;
            const int pos = 8 * ((fr >> 2) & 1) + (fr & 3) + 4 * (fr >> 3);
#pragma unroll
            for (int ai = 0; ai < 2; ++ai)
#pragma unroll
                for (int m = 0; m < 4; ++m) {
                    const int row = row0 + ai * HALF + m * 16; const int b = row >> 13, t = row & 8191; const int tb = (t & 48) + pos; const int tT = t >> 6;
#pragma unroll
                    for (int bj = 0; bj < 2; ++bj)
#pragma unroll
                        for (int n = 0; n < 2; ++n)
#pragma unroll
                            for (int e = 0; e < 4; ++e) { const int col = cl + 32 * bj + 4 * n + e; const unsigned w = cvt_pk_bf16(acc[ai][bj][m][n][e], 0.f);
                                const int hh = col >> dsh, dd = col & ((1 << dsh) - 1);
                                VT[((size_t)(b * (512 >> dsh) + hh) * 128 + tT) * (size_t)(64 << dsh) + dd * 64 + tb] = (bf16_t)(w & 0xffffu); }
                }
            return;
        }
        bf16_t* O = kind == 0 ? SBQ : kind == 1 ? SBK : kind == 3 ? SBG : kind == 4 ? DFQ : kind == 5 ? DFK : DFG;
        f32x4 gv[2][2];
        if (kind == 4 || kind == 5) { const float* g = (kind == 4) ? qg : kg;
#pragma unroll
            for (int bj = 0; bj < 2; ++bj)
#pragma unroll
                for (int n = 0; n < 2; ++n) gv[bj][n] = *(const f32x4*)(g + 32 * bj + 8 * fq + 4 * n); }
#pragma unroll
        for (int ai = 0; ai < 2; ++ai)
#pragma unroll
            for (int m = 0; m < 4; ++m) {
                const int row = row0 + ai * HALF + m * 16;
                f32x4 v[2][2];
#pragma unroll
                for (int bj = 0; bj < 2; ++bj)
#pragma unroll
                    for (int n = 0; n < 2; ++n) v[bj][n] = acc[ai][bj][m][n];
                if (kind == 4 || kind == 5) {
                    float ss = 0.f;
#pragma unroll
                    for (int bj = 0; bj < 2; ++bj)
#pragma unroll
                        for (int n = 0; n < 2; ++n) { const f32x4 x = v[bj][n]; ss += (x[0] * x[0] + x[1] * x[1]) + (x[2] * x[2] + x[3] * x[3]); }
                    ss += __shfl_xor(ss, 16); ss += __shfl_xor(ss, 32);
                    float rs = 1.0f / sqrtf(ss * (1.0f / 64.0f) + 1e-6f); if (kind == 4) rs *= 0.125f * 1.4426950408889634f;
#pragma unroll
                    for (int bj = 0; bj < 2; ++bj)
#pragma unroll
                        for (int n = 0; n < 2; ++n) v[bj][n] = v[bj][n] * rs * gv[bj][n];
                } else if (kind == 0) {
#pragma unroll
                    for (int bj = 0; bj < 2; ++bj)
#pragma unroll
                        for (int n = 0; n < 2; ++n) v[bj][n] = v[bj][n] * (0.125f * 1.4426950408889634f);
                } else if (kind == 3 || kind == 7) {
#pragma unroll
                    for (int bj = 0; bj < 2; ++bj)
#pragma unroll
                        for (int n = 0; n < 2; ++n)
#pragma unroll
                            for (int e = 0; e < 4; ++e) { const float x = v[bj][n][e]; v[bj][n][e] = x * __builtin_amdgcn_rcpf(1.0f + __builtin_amdgcn_exp2f(-1.4426950408889634f * x)); }
                }
                bf16_t* rowp = O + (size_t)row * 512 + cl;
#pragma unroll
                for (int bj = 0; bj < 2; ++bj) { u32x4 w; w.x = cvt_pk_bf16(v[bj][0][0], v[bj][0][1]); w.y = cvt_pk_bf16(v[bj][0][2], v[bj][0][3]); w.z = cvt_pk_bf16(v[bj][1][0], v[bj][1][1]); w.w = cvt_pk_bf16(v[bj][1][2], v[bj][1][3]);
                    if (kind == 1 || kind == 5) *(u32x4*)(rowp + 32 * bj) = w; else __builtin_nontemporal_store(w, (u32x4*)(rowp + 32 * bj)); }
            }
    }
};
struct EpiOut {
    static constexpr bool PERM = true, AFTER_DRAIN = false;
    const float* x; const float* mod; float* out;
    __device__ __forceinline__ void operator()(const f32x4 (&acc)[2][2][4][2], const Unit& u, int wr, int wc, int fr, int fq) const {
        const int row0 = u.pm * BM + wr * 64 + fr, col0 = u.pn * BM + wc * 32 + 8 * fq; const int b = u.pm >> 5;
#pragma unroll
        for (int bj = 0; bj < 2; ++bj) { const int col = col0 + bj * HALF; const f32x4 g0 = *(const f32x4*)(mod + b * 3072 + 2048 + col), g1 = *(const f32x4*)(mod + b * 3072 + 2048 + col + 4);
#pragma unroll
            for (int ai = 0; ai < 2; ++ai)
#pragma unroll
                for (int m = 0; m < 4; ++m) { const size_t off = (size_t)(row0 + ai * HALF + m * 16) * 1024 + col; const f32x4 x0 = __builtin_nontemporal_load((const f32x4*)(x + off)), x1 = __builtin_nontemporal_load((const f32x4*)(x + off + 4));
                    __builtin_nontemporal_store(x0 + g0 * acc[ai][bj][m][0], (f32x4*)(out + off)); __builtin_nontemporal_store(x1 + g1 * acc[ai][bj][m][1], (f32x4*)(out + off + 4)); } }
    }
};
}

namespace att {
typedef unsigned short bf16_t;
typedef short bf16x8 __attribute__((ext_vector_type(8)));
typedef float f32x16 __attribute__((ext_vector_type(16)));
typedef float f32x4 __attribute__((ext_vector_type(4)));
typedef float f32x2 __attribute__((ext_vector_type(2)));
typedef __bf16 bf16x2 __attribute__((ext_vector_type(2)));
typedef unsigned u32x4 __attribute__((ext_vector_type(4)));
typedef unsigned u32x2 __attribute__((ext_vector_type(2)));
#define MFMA32(a, b, c) __builtin_amdgcn_mfma_f32_32x32x16_bf16((a), (b), (c), 0, 0, 0)
#define DI __device__ __forceinline__
#define FENCE() do { asm volatile("" ::: "memory"); __builtin_amdgcn_sched_barrier(0); } while (0)
DI unsigned cvtpk(float lo, float hi) { f32x2 v = {lo, hi}; bf16x2 b = __builtin_convertvector(v, bf16x2); return __builtin_bit_cast(unsigned, b); }
DI float bf_lo(unsigned w) { return __uint_as_float(w << 16); }
DI float bf_hi(unsigned w) { return __uint_as_float(w & 0xffff0000u); }
DI int crow(int r, int hi) { return (r & 3) + 8 * (r >> 2) + 4 * hi; }
DI float ex2(float x) { return __builtin_amdgcn_exp2f(x); }
DI float lg2(float x) { return __builtin_amdgcn_logf(x); }
template <int S> DI bf16x8 pack8(const f32x16& x) { u32x4 p; p[0] = cvtpk(x[8 * S], x[8 * S + 1]); p[1] = cvtpk(x[8 * S + 2], x[8 * S + 3]); p[2] = cvtpk(x[8 * S + 4], x[8 * S + 5]); p[3] = cvtpk(x[8 * S + 6], x[8 * S + 7]); return __builtin_bit_cast(bf16x8, p); }
template <int S> DI void pack8_hl(const f32x16& x, bf16x8& h, bf16x8& l) { u32x4 p, q;
#pragma unroll
    for (int i = 0; i < 4; ++i) { const float a = x[8 * S + 2 * i], b = x[8 * S + 2 * i + 1]; const unsigned w = cvtpk(a, b); p[i] = w; q[i] = cvtpk(a - bf_lo(w), b - bf_hi(w)); }
    h = __builtin_bit_cast(bf16x8, p); l = __builtin_bit_cast(bf16x8, q); }
DI int off128(int row, int c) { return row * 128 + ((c ^ ((row >> 1) & 7)) << 4); }
DI int off256(int row, int c) { return row * 256 + ((c ^ (row & 15)) << 4); }
DI bf16x8 ldsv(const LAS char* p) { return *(const LAS bf16x8*)p; }
DI f32x16 splat16(float v) { f32x16 r;
#pragma unroll
    for (int i = 0; i < 16; ++i) r[i] = v;
    return r; }

DI void swz_in(u32x4 t, u32x2& g0, u32x2& g1) { auto r0 = __builtin_amdgcn_permlane32_swap(t.x, t.z, false, false); auto r1 = __builtin_amdgcn_permlane32_swap(t.y, t.w, false, false); g0.x = r0[0]; g0.y = r1[0]; g1.x = r0[1]; g1.y = r1[1]; }
DI u32x4 swz_out(u32x2 w0, u32x2 w1) { auto r0 = __builtin_amdgcn_permlane32_swap(w0.x, w1.x, false, false); auto r1 = __builtin_amdgcn_permlane32_swap(w0.y, w1.y, false, false); u32x4 o; o.x = r0[0]; o.y = r1[0]; o.z = r0[1]; o.w = r1[1]; return o; }
DI void glds16(const void* gsrc, unsigned lds_dst) { unsigned keep;
    asm volatile("s_mov_b32 %0, m0\n\ts_mov_b32 m0, %2\n\ts_nop 0\n\tglobal_load_lds_dwordx4 %1, off\n\ts_mov_b32 m0, %0" : "=&s"(keep) : "v"(gsrc), "s"(lds_dst) : "memory"); }
#define WAIT_BAR0() asm volatile("s_waitcnt vmcnt(0) lgkmcnt(0)\n\ts_barrier" ::: "memory")
#define WAIT_BAR1() asm volatile("s_waitcnt vmcnt(1) lgkmcnt(0)\n\ts_barrier" ::: "memory")
#define WAIT_BAR4() asm volatile("s_waitcnt vmcnt(4) lgkmcnt(0)\n\ts_barrier" ::: "memory")
#define RFL(x) ((unsigned)__builtin_amdgcn_readfirstlane((int)(x)))

DI void sb_unit(LAS char* lds, int b, int h, int qb, const bf16_t* __restrict__ Q, const bf16_t* __restrict__ K, const bf16_t* __restrict__ VT, const bf16_t* __restrict__ G, bf16_t* __restrict__ MIX) {
    int tid_ = threadIdx.x; asm volatile("" : "+v"(tid_));
    const int tid = tid_, lane = tid & 63, r32 = lane & 31, hi = lane >> 5; const int wid = __builtin_amdgcn_readfirstlane(tid >> 6);
    const int q0 = qb * 256, qw0 = q0 + 32 * wid, tq = qw0 + r32;
    volatile LAS int* flags = (volatile LAS int*)(lds + MISC_OFF);
    const unsigned lds0 = (unsigned)(uintptr_t)lds;
    bf16x8 qf[4];
#pragma unroll
    for (int d0 = 0; d0 < 4; ++d0) qf[d0] = __builtin_nontemporal_load((const bf16x8*)(Q + (size_t)(b * SEQ + tq) * 512 + h * 64 + d0 * 16 + hi * 8));
    bf16x8 tp0, tp1, ones;
#pragma unroll
    for (int j = 0; j < 8; ++j) { const int kvk = 8 * (j >> 2) + 4 * hi + (j & 3); tp0[j] = (kvk > r32) ? (short)0x3F80 : (short)0; tp1[j] = (16 + kvk > r32) ? (short)0x3F80 : (short)0; ones[j] = (short)0x3F80; }
    const int drow = 8 * wid + (lane >> 3), dch = (lane & 7) ^ ((drow >> 1) & 7);
    const bf16_t* ksrc = K + (size_t)(b * SEQ + drow) * 512 + h * 64 + dch * 8;
    const bf16_t* vsrc = VT + (size_t)(b * 8 + h) * (SEQ * 64) + drow * 64 + dch * 8;
#define SB_DMA(T, st) do { const unsigned base_ = lds0 + (st) * 16384 + wid * 1024; glds16(ksrc + (size_t)(T) * 64 * 512, RFL(base_)); glds16(vsrc + (size_t)(T) * 4096, RFL(base_ + 8192)); } while (0)
    f32x16 o0 = splat16(0.f), o1 = splat16(0.f); float carry = 0.f; int done = 0;
    const int nt = (q0 + 256) / 64;
    WAIT_BAR0();
    SB_DMA(nt - 1, 0);
    for (int T = nt - 1, it = 0; T >= 0; --T, ++it) {
        WAIT_BAR0();
        if (it > 0) { volatile LAS int* fl = flags + ((it & 1) ^ 1) * 8; const int all = fl[0] & fl[1] & fl[2] & fl[3] & fl[4] & fl[5] & fl[6] & fl[7]; if (all) break; }
        if (T > 0) SB_DMA(T - 1, (it + 1) & 1);
        const LAS char* Kt = lds + (it & 1) * 16384; const LAS char* Vt = Kt + 8192;
        const int kv0 = 64 * T;
        if (kv0 < qw0 + 31 && !done) {
            f32x16 p0 = splat16(0.f), p1 = splat16(0.f);
#pragma unroll
            for (int d0 = 0; d0 < 4; ++d0) { const bf16x8 k0 = ldsv(Kt + off128(r32, 2 * d0 + hi)), k1 = ldsv(Kt + off128(32 + r32, 2 * d0 + hi)); p0 = MFMA32(k0, qf[d0], p0); p1 = MFMA32(k1, qf[d0], p1); }
            const bool diag = (kv0 + 63 >= qw0);
            f32x16 L0, L1;
#pragma unroll
            for (int r = 0; r < 16; ++r) {
                { const float z = p0[r]; const float lg = (z > 30.f) ? z : lg2(1.0f + ex2(z)); const bool valid = !diag || (kv0 + crow(r, hi) < tq); L0[r] = valid ? -lg : 0.f; p0[r] = valid ? (z - lg) : -1e30f; }
                { const float z = p1[r]; const float lg = (z > 30.f) ? z : lg2(1.0f + ex2(z)); const bool valid = !diag || (kv0 + 32 + crow(r, hi) < tq); L1[r] = valid ? -lg : 0.f; p1[r] = valid ? (z - lg) : -1e30f; }
            }
            const bf16x8 Lh0 = pack8<0>(L0), Lh1 = pack8<1>(L0), Lh2 = pack8<0>(L1), Lh3 = pack8<1>(L1);
            f32x16 C0 = splat16(carry), C1 = C0;
            C0 = MFMA32(tp0, Lh0, C0); C0 = MFMA32(tp1, Lh1, C0); C0 = MFMA32(ones, Lh2, C0); C0 = MFMA32(ones, Lh3, C0);
            C1 = MFMA32(tp0, Lh2, C1); C1 = MFMA32(tp1, Lh3, C1);
            const float cn = C0[0] + L0[0];
            carry = __shfl(cn, r32, 64);
#pragma unroll
            for (int r = 0; r < 16; ++r) { p0[r] = ex2(p0[r] + C0[r]); p1[r] = ex2(p1[r] + C1[r]); }
            const bf16x8 pa0 = pack8<0>(p0), pa1 = pack8<1>(p0), pa2 = pack8<0>(p1), pa3 = pack8<1>(p1);
#define SB_PV(ks, pa) { const bf16x8 v0 = ldsv(Vt + off128(r32, 2 * (ks) + hi)), v1 = ldsv(Vt + off128(32 + r32, 2 * (ks) + hi)); o0 = MFMA32(v0, pa, o0); o1 = MFMA32(v1, pa, o1); }
            SB_PV(0, pa0) SB_PV(1, pa1) SB_PV(2, pa2) SB_PV(3, pa3)
#undef SB_PV
            done = __all(carry < -152.f) ? 1 : 0;
        }
        if (lane == 0) flags[(it & 1) * 8 + wid] = done;
    }
#undef SB_DMA
    const size_t trow = (size_t)(b * SEQ + tq);
#pragma unroll
    for (int db = 0; db < 2; ++db)
#pragma unroll
        for (int gp = 0; gp < 2; ++gp) { const int dc = 32 * db + 16 * gp + 8 * hi; const f32x16& o = db ? o1 : o0;
            u32x2 g0, g1; swz_in(__builtin_nontemporal_load((const u32x4*)(G + trow * 512 + h * 64 + dc)), g0, g1);
            u32x2 w0, w1; const int r0 = 8 * gp, r1 = 8 * gp + 4;
            w0.x = cvtpk(o[r0] * bf_lo(g0.x), o[r0 + 1] * bf_hi(g0.x)); w0.y = cvtpk(o[r0 + 2] * bf_lo(g0.y), o[r0 + 3] * bf_hi(g0.y));
            w1.x = cvtpk(o[r1] * bf_lo(g1.x), o[r1 + 1] * bf_hi(g1.x)); w1.y = cvtpk(o[r1 + 2] * bf_lo(g1.y), o[r1 + 3] * bf_hi(g1.y));
            *(u32x4*)(MIX + trow * 1024 + h * 64 + dc) = swz_out(w0, w1); }
}

struct DfCtx { int kad[4], vad[4]; bf16x8 qf[4]; float c0, sl; int tq, qw0, hi; };
#define PIN4(x) asm volatile("" : "+v"(x[0]), "+v"(x[1]), "+v"(x[2]), "+v"(x[3]))
#define MEMFENCE() asm volatile("" ::: "memory")
DI void df_scores(const LAS char* Kst, const DfCtx& c, f32x16& p, f32x16& q, int kv0) {
    const float bb = c.c0 + c.sl * (float)kv0;
    bf16x8 k0[4], k1[4];
#pragma unroll
    for (int d0 = 0; d0 < 4; ++d0) k0[d0] = ldsv(Kst + c.kad[d0]);
    MEMFENCE();
#pragma unroll
    for (int r = 0; r < 16; ++r) p[r] = __builtin_fmaf(c.sl, (float)((r & 3) + 8 * (r >> 2)), bb);
    PIN4(k0);
#pragma unroll
    for (int d0 = 0; d0 < 4; ++d0) p = MFMA32(k0[d0], c.qf[d0], p);
#pragma unroll
    for (int d0 = 0; d0 < 4; ++d0) k1[d0] = ldsv(Kst + c.kad[d0] + 8192);
    MEMFENCE();
    { const float ba = bb + c.sl * 32.0f;
#pragma unroll
      for (int r = 0; r < 16; ++r) q[r] = __builtin_fmaf(c.sl, (float)((r & 3) + 8 * (r >> 2)), ba); }
    PIN4(k1);
#pragma unroll
    for (int d0 = 0; d0 < 4; ++d0) q = MFMA32(k1[d0], c.qf[d0], q);
}
template <bool PV> DI void df_pv_exp(const LAS char* Vst, const DfCtx& c, const bf16x8 (&pw)[4], f32x16 (&O)[4], f32x16& p, f32x16& q, bf16x8 (&pwN)[4], float& l, bool dg, int kv0) {
    bf16x8 v0[4];
    if (PV) {
#pragma unroll
        for (int ks = 0; ks < 4; ++ks) v0[ks] = ldsv(Vst + c.vad[ks]);
        MEMFENCE(); }
#pragma unroll
    for (int r = 0; r < 16; ++r) p[r] = ex2(p[r]);
    if (PV) {
        PIN4(v0);
#pragma unroll
        for (int ks = 0; ks < 4; ++ks) O[0] = MFMA32(v0[ks], pw[ks], O[0]);
#pragma unroll
        for (int ks = 0; ks < 4; ++ks) v0[ks] = ldsv(Vst + c.vad[ks] + 4096);
        MEMFENCE(); }
#pragma unroll
    for (int r = 0; r < 16; ++r) q[r] = ex2(q[r]);
    if (PV) {
        PIN4(v0);
#pragma unroll
        for (int ks = 0; ks < 4; ++ks) O[1] = MFMA32(v0[ks], pw[ks], O[1]);
#pragma unroll
        for (int ks = 0; ks < 4; ++ks) v0[ks] = ldsv(Vst + c.vad[ks] + 8192);
        MEMFENCE(); }
    if (dg) { const int lim = c.tq - kv0 - 4 * c.hi;
#pragma unroll
        for (int r = 0; r < 16; ++r) { if ((r & 3) + 8 * (r >> 2) > lim) p[r] = 0.f; if (32 + (r & 3) + 8 * (r >> 2) > lim) q[r] = 0.f; } }
    float ls = 0.f;
#pragma unroll
    for (int r = 0; r < 16; ++r) ls += p[r] + q[r];
    l += ls;
    if (PV) {
        PIN4(v0);
#pragma unroll
        for (int ks = 0; ks < 4; ++ks) O[2] = MFMA32(v0[ks], pw[ks], O[2]);
#pragma unroll
        for (int ks = 0; ks < 4; ++ks) v0[ks] = ldsv(Vst + c.vad[ks] + 12288);
        MEMFENCE(); }
    pwN[0] = pack8<0>(p); pwN[1] = pack8<1>(p); pwN[2] = pack8<0>(q); pwN[3] = pack8<1>(q);
    if (PV) {
        PIN4(v0);
#pragma unroll
        for (int ks = 0; ks < 4; ++ks) O[3] = MFMA32(v0[ks], pw[ks], O[3]);
    }
}
constexpr int DF_KR = 0, DF_VR = 65536;
DI void df_unit(LAS char* lds, int b, int h, int qb, const bf16_t* __restrict__ Q, const bf16_t* __restrict__ K, const bf16_t* __restrict__ VT, const bf16_t* __restrict__ G, bf16_t* __restrict__ MIX,
                float lam, float Mb  , const float* __restrict__ subg) {
    int tid_ = threadIdx.x; asm volatile("" : "+v"(tid_));
    const int tid = tid_, lane = tid & 63, r32 = lane & 31, hi = lane >> 5; const int wid = __builtin_amdgcn_readfirstlane(tid >> 6);
    const int mp = wid >> 2, wq = wid & 3;
    const int q0 = qb * 128, qw0 = q0 + 32 * wq, tq = qw0 + r32;
    LAS float* Xch = (LAS float*)lds;
    const unsigned lds0 = (unsigned)(uintptr_t)lds;
    DfCtx c; c.qw0 = qw0; c.tq = 0; c.hi = 0;
#pragma unroll
    for (int d0 = 0; d0 < 4; ++d0) c.qf[d0] = __builtin_nontemporal_load((const bf16x8*)(Q + (size_t)(b * SEQ + tq) * 512 + h * 128 + mp * 64 + d0 * 16 + hi * 8));
    { const int kx = hi ^ (r32 & 15), vx = hi ^ ((r32 >> 1) & 7);
#pragma unroll
      for (int i = 0; i < 4; ++i) { c.kad[i] = r32 * 256 + (((8 * mp + 2 * i) ^ kx) << 4); c.vad[i] = r32 * 128 + (((2 * i) ^ vx) << 4); } }
    const int krow = 4 * wid + (lane >> 4), kch = (lane & 15) ^ (krow & 15);
    const int vrow = 8 * wid + (lane >> 3), vch = (lane & 7) ^ ((vrow >> 1) & 7);
    const bf16_t* ksrc = K + (size_t)(b * SEQ + krow) * 512 + h * 128 + kch * 8;
    const bf16_t* vsrc = VT + (size_t)(b * 4 + h) * (SEQ * 128) + vrow * 64 + vch * 8;
#define DF_DMA(T, ko_, vo_) do { const unsigned kb_ = lds0 + DF_KR + (ko_) + wid * 1024, vb_ = lds0 + DF_VR + (vo_) + wid * 1024; const bf16_t* kp_ = ksrc + (size_t)(T) * 64 * 512; const bf16_t* vp_ = vsrc + (size_t)(T) * 8192; \
        glds16(kp_, RFL(kb_)); glds16(kp_ + 32 * 512, RFL(kb_ + 8192)); glds16(vp_, RFL(vb_)); glds16(vp_ + 4096, RFL(vb_ + 8192)); } while (0)
    f32x16 O[4];
#pragma unroll
    for (int i = 0; i < 4; ++i) O[i] = splat16(0.f);
    float l = 0.f;
    const float slope2 = ex2(-2.0f * (float)(h + 1)) * LOG2E;
    c.sl = slope2; c.c0 = -slope2 * (float)(tq - 4 * hi) - Mb;
    const int nt = (q0 + 128) / 64;
    int T0 = 0; { float mb2 = Mb; asm volatile("" : "+s"(mb2)); const int W = (int)ceilf((150.0f + 2.0f * mb2) / slope2) + 1; const int x = q0 - 63 - W; if (x >= 0) T0 = x / 64 + 1; }
    WAIT_BAR0();
    DF_DMA(T0, 0, 0); if (T0 + 1 < nt) DF_DMA(T0 + 1, 16384, 16384);
    bf16x8 pw[4], pwN[4]; f32x16 p, q;
#define DF_HEAD(so_, T) do { if ((T) + 1 < nt) WAIT_BAR4(); else WAIT_BAR0(); if ((T) + 2 < nt) DF_DMA((T) + 2, ((so_) + 32768) & 65535, ((so_) + 32768) & 65535); } while (0)
#define DF_ROT() do { _Pragma("unroll") for (int i = 0; i < 4; ++i) pw[i] = pwN[i]; } while (0)
    c.tq = tq; c.hi = hi;
    DF_HEAD(0, T0); df_scores(lds + DF_KR, c, p, q, 64 * T0); df_pv_exp<false>(lds + DF_VR, c, pw, O, p, q, pwN, l, T0 >= nt - 2, 64 * T0); DF_ROT();
    bool havep = true;
#define DF_MAIN(so_, T) do { DF_HEAD(so_, T); df_scores(lds + DF_KR + (so_), c, p, q, 64 * (T)); df_pv_exp<true>(lds + DF_VR + (((so_) + 49152) & 65535), c, pw, O, p, q, pwN, l, false, 64 * (T)); DF_ROT(); } while (0)
    int T = T0 + 1;
    for (; T + 4 <= nt - 2; T += 4) { DF_MAIN(16384, T); DF_MAIN(32768, T + 1); DF_MAIN(49152, T + 2); DF_MAIN(0, T + 3); }
    int so = 16384;
    { int tt_ = threadIdx.x; asm volatile("" : "+v"(tt_)); c.tq = q0 + 32 * wq + (tt_ & 31); c.hi = (tt_ & 63) >> 5; }
#pragma unroll 1
    for (; T < nt; ++T) {
        DF_HEAD(so, T);
        const bool dg = T >= nt - 2; const int kv0 = 64 * T; const int vpo = (so + 49152) & 65535;
        if (!(dg && kv0 > qw0 + 31)) { df_scores(lds + DF_KR + so, c, p, q, kv0); df_pv_exp<true>(lds + DF_VR + vpo, c, pw, O, p, q, pwN, l, dg, kv0); DF_ROT(); }
        else { if (havep) {
#pragma unroll
                for (int db = 0; db < 4; ++db)
#pragma unroll
                    for (int ks = 0; ks < 4; ++ks) O[db] = MFMA32(ldsv(lds + DF_VR + vpo + c.vad[ks] + db * 4096), pw[ks], O[db]); }
               havep = false; }
        so = (so + 16384) & 65535;
    }
    const int vprev = ((nt - 1 - T0) & 3) * 16384;
#undef DF_HEAD
#undef DF_ROT
#undef DF_MAIN
    if (havep) {
#pragma unroll
        for (int db = 0; db < 4; ++db)
#pragma unroll
            for (int ks = 0; ks < 4; ++ks) O[db] = MFMA32(ldsv(lds + DF_VR + vprev + c.vad[ks] + db * 4096), pw[ks], O[db]); }
#undef DF_DMA
    int te_ = threadIdx.x; asm volatile("" : "+v"(te_));
    const int lane2 = te_ & 63, hi2 = lane2 >> 5, tq2 = q0 + 32 * wq + (lane2 & 31);
    l += __shfl_xor(l, 32);
    WAIT_BAR0();
    if (mp == 1) { const float i2 = lam / l;
#pragma unroll
        for (int db = 0; db < 4; ++db)
#pragma unroll
            for (int r = 0; r < 16; ++r) Xch[(wq * 64 + db * 16 + r) * 64 + lane2] = O[db][r] * i2; }
    WAIT_BAR0();
    if (mp == 0) {
        const float i1 = 1.0f / l; float ss = 0.f;
#pragma unroll
        for (int db = 0; db < 4; ++db)
            {
#pragma unroll
              for (int r = 0; r < 16; ++r) { const float v = O[db][r] * i1 - Xch[(wq * 64 + db * 16 + r) * 64 + lane2]; O[db][r] = v; ss += v * v; } asm volatile("" : "+v"(O[db]), "+v"(ss) :: "memory"); }
        ss += __shfl_xor(ss, 32);
        const float rs = 0.8f / sqrtf(ss * (1.0f / 128.0f) + EPS);
        const size_t trow = (size_t)(b * SEQ + tq2);
#pragma unroll
        for (int db = 0; db < 4; ++db)
#pragma unroll
            for (int gp = 0; gp < 2; ++gp) { const int dc = 32 * db + 16 * gp + 8 * hi2, d0 = 32 * db + 16 * gp + 4 * hi2, d1 = d0 + 8; const int r0 = 8 * gp, r1 = 8 * gp + 4;
                u32x2 g0, g1; swz_in(__builtin_nontemporal_load((const u32x4*)(G + trow * 512 + h * 128 + dc)), g0, g1);
                const f32x4 s0 = *(const f32x4*)(subg + d0), s1 = *(const f32x4*)(subg + d1);
                u32x2 w0, w1;
                w0.x = cvtpk(O[db][r0] * rs * s0[0] * bf_lo(g0.x), O[db][r0 + 1] * rs * s0[1] * bf_hi(g0.x)); w0.y = cvtpk(O[db][r0 + 2] * rs * s0[2] * bf_lo(g0.y), O[db][r0 + 3] * rs * s0[3] * bf_hi(g0.y));
                w1.x = cvtpk(O[db][r1] * rs * s1[0] * bf_lo(g1.x), O[db][r1 + 1] * rs * s1[1] * bf_hi(g1.x)); w1.y = cvtpk(O[db][r1 + 2] * rs * s1[2] * bf_lo(g1.y), O[db][r1 + 3] * rs * s1[3] * bf_hi(g1.y));
                *(u32x4*)(MIX + trow * 1024 + 512 + h * 128 + dc) = swz_out(w0, w1); asm volatile("" ::: "memory"); }
    }
}
}

typedef unsigned short bf16;
typedef unsigned v4u __attribute__((ext_vector_type(4)));
typedef float f32x4 __attribute__((ext_vector_type(4)));
__device__ __forceinline__ unsigned f2bf(float f) { unsigned u = __builtin_bit_cast(unsigned, f); return (u + 0x7fffu + ((u >> 16) & 1u)) >> 16; }
__device__ __forceinline__ unsigned pk2(float lo, float hi) { return f2bf(lo) | (f2bf(hi) << 16); }
__device__ __forceinline__ float wave_sum(float v) {
#pragma unroll
    for (int o = 1; o < 64; o <<= 1) v += __shfl_xor(v, o);
    return v; }
__device__ __forceinline__ float wave_max(float v) {
#pragma unroll
    for (int o = 1; o < 64; o <<= 1) v = fmaxf(v, __shfl_xor(v, o));
    return v; }
template <bool PERMROWS> __device__ __forceinline__ void transpose_item(const float* W, int K, int N, bf16* WT, LAS float* scr, int item, int lane) {
    const int nblk = N / 32, kb = item / nblk, nb = item % nblk, k0 = 64 * kb, n0 = 32 * nb;
    float tv[32];
#pragma unroll
    for (int i = 0; i < 32; ++i) tv[i] = __builtin_nontemporal_load(W + (size_t)(k0 + 2 * i + (lane >> 5)) * N + n0 + (lane & 31));
#pragma unroll
    for (int i = 0; i < 32; ++i) scr[(2 * i + (lane >> 5)) * 33 + (lane & 31)] = tv[i];
    asm volatile("s_waitcnt lgkmcnt(0)" ::: "memory");
    int r0 = n0;
    if (PERMROWS) { const int L0 = n0 & 255; r0 = (n0 & ~255) + 128 * ((L0 >> 5) & 1) + 32 * (L0 >> 6); }
    const int c = lane & 7;
#pragma unroll
    for (int j = 0; j < 4; ++j) { const int n = (lane >> 3) + 8 * j; const LAS float* s = scr + (8 * c) * 33 + n;
        v4u o; o.x = pk2(s[0 * 33], s[1 * 33]); o.y = pk2(s[2 * 33], s[3 * 33]); o.z = pk2(s[4 * 33], s[5 * 33]); o.w = pk2(s[6 * 33], s[7 * 33]);
        *(v4u*)(WT + (size_t)(r0 + n) * K + k0 + 8 * c) = o; }
    asm volatile("s_waitcnt lgkmcnt(0)" ::: "memory");
}

#define XB_TMO      128
#define XB_XCNT(j)  (256  + 64 * (j))
#define XB_XSUB(j)  (1280 + 64 * (j))
#define XB_XGEN(j)  (2304 + 64 * (j))
#define XB_TOP      3328
#define XB_TOPGEN   3392
#define XCD_BAR_WORDS 3456
#define XB_SPIN_CAP (1u << 18)

__device__ __forceinline__ unsigned xb_ld(unsigned* p)              { return __hip_atomic_load(p, __ATOMIC_RELAXED, __HIP_MEMORY_SCOPE_AGENT); }
__device__ __forceinline__ unsigned xb_add(unsigned* p, unsigned v) { return __hip_atomic_fetch_add(p, v, __ATOMIC_RELAXED, __HIP_MEMORY_SCOPE_AGENT); }
__device__ __forceinline__ unsigned xb_xcc_id() { return (unsigned)__builtin_amdgcn_s_getreg((3 << 11) | 20) & 0xFu; }
#define XB_SPIN(cond, bar) do { unsigned _sp = 0; while (cond) { __builtin_amdgcn_s_sleep(1); \
    if ((++_sp & 255u) == 0u) { if (xb_ld(&(bar)[XB_TMO])) break; if (_sp > XB_SPIN_CAP) { atomicAdd(&(bar)[XB_TMO], 1u); break; } } } } while (0)

struct XcdBarrier {
    unsigned* bar; unsigned x;
    volatile LAS unsigned* st;
};

__device__ __forceinline__ XcdBarrier xcd_barrier_post(unsigned* bar, volatile LAS unsigned* st) {
    XcdBarrier b; b.bar = bar; b.x = xb_xcc_id(); b.st = st;
    if (threadIdx.x == 0) (void)xb_add(&bar[XB_XCNT(b.x)], 1u);
    return b;
}
__device__ __forceinline__ void xcd_barrier_complete(unsigned* bar, unsigned x, unsigned& nloc, unsigned& nx) {
    const unsigned G = gridDim.x * gridDim.y * gridDim.z;
    unsigned sum, cnt, mine, sp = 0u;
    for (;;) {
        sum = 0u; cnt = 0u; mine = 0u;
#pragma unroll
        for (unsigned j = 0; j < 16; ++j) { const unsigned c = xb_ld(&bar[XB_XCNT(j)]); sum += c; cnt += (c > 0u) ? 1u : 0u; mine = (j == x) ? c : mine; }
        if (sum == G) break;
        __builtin_amdgcn_s_sleep(1);
        if ((++sp & 255u) == 0u) { if (xb_ld(&bar[XB_TMO])) break; if (sp > XB_SPIN_CAP) { atomicAdd(&bar[XB_TMO], 1u); break; } }
    }
    nloc = mine > 0u ? mine : 1u; nx = cnt > 0u ? cnt : 1u;
}

__device__ __forceinline__ void xcd_barrier(const XcdBarrier& b) {
    asm volatile("s_waitcnt vmcnt(0)" ::: "memory");
    __syncthreads();
    if (threadIdx.x == 0) {
        unsigned* bar = b.bar;
        __builtin_amdgcn_s_waitcnt(0);
        unsigned nloc = b.st[0], nx = b.st[1];
        if (nloc == 0u) { xcd_barrier_complete(bar, b.x, nloc, nx); b.st[0] = nloc; b.st[1] = nx; }
        const unsigned old = xb_add(&bar[XB_XSUB(b.x)], 1u);
        const unsigned gen = old / nloc;
        if (old + 1u == (gen + 1u) * nloc) {
            __builtin_amdgcn_fence(__ATOMIC_RELEASE, "agent");
            asm volatile("s_waitcnt vmcnt(0)" ::: "memory");
            const unsigned og = xb_add(&bar[XB_TOP], 1u);
            const unsigned tg = og / nx;
            if (og + 1u == (tg + 1u) * nx) xb_add(&bar[XB_TOPGEN], 1u);
            else XB_SPIN(xb_ld(&bar[XB_TOPGEN]) == tg, bar);
            __builtin_amdgcn_fence(__ATOMIC_ACQUIRE, "agent");
            xb_add(&bar[XB_XGEN(b.x)], 1u);
            asm volatile("s_waitcnt vmcnt(0)" ::: "memory");
        } else {
            XB_SPIN(xb_ld(&bar[XB_XGEN(b.x)]) == gen, bar);
            __builtin_amdgcn_fence(__ATOMIC_ACQUIRE, "agent");
            asm volatile("s_waitcnt vmcnt(0)" ::: "memory");
        }
    }
    __syncthreads();
}

struct Args { const float *x, *c, *norm_g, *w_ada, *b_ada, *w_in, *qg, *kg, *lq1, *lk1, *lq2, *lk2, *subg, *w_out; float* out; unsigned char* ws; };

__global__ void __launch_bounds__(512) fwd_megakernel(Args a) {
    extern __shared__ __attribute__((aligned(16))) unsigned char lds_raw[];
    cg::grid_group grid = cg::this_grid();
    LAS unsigned char* lds = (LAS unsigned char*)lds_raw;
    const int tid = threadIdx.x, lane = tid & 63; const int wid = __builtin_amdgcn_readfirstlane(tid >> 6);
    const int blk = blockIdx.x, G = gridDim.x;
    unsigned char* ws = a.ws;
    float* mod = (float*)(ws + WS_MOD);
    unsigned* barw = (unsigned*)(ws + WS_BAR);
    volatile LAS unsigned* bst = (volatile LAS unsigned*)(lds + LDSCTL_OFF);
    if (tid < 16) bst[tid] = 0u;
    __syncthreads();
    XcdBarrier bar = xcd_barrier_post(barw, bst);
    if (a.ws == nullptr) grid.sync();
    bf16* WinT = (bf16*)(ws + WS_WIN); bf16* WoutT = (bf16*)(ws + WS_WOUT); bf16* XN = (bf16*)(ws + WS_XN);
    bf16* SBQ = (bf16*)(ws + WS_SBQ); bf16* SBK = (bf16*)(ws + WS_SBK); bf16* SBG = (bf16*)(ws + WS_SBG);
    bf16* DFQ = (bf16*)(ws + WS_DFQ); bf16* DFK = (bf16*)(ws + WS_DFK); bf16* DFG = (bf16*)(ws + WS_DFG);
    bf16* SBVT = (bf16*)(ws + WS_SBVT); bf16* DFVT = (bf16*)(ws + WS_DFVT); bf16* MIX = (bf16*)(ws + WS_MIX);

#ifndef PHM
#define PHM 31
#endif
#ifndef REP_P01
#define REP_P01 1
#endif
    for (int rep01 = 0; rep01 < REP_P01; ++rep01) {
#if PHM & 1
    if (blk < 192) {
        const int c0 = 16 * blk, cq = tid & 3, kq = tid >> 2;
        f32x4 a0 = {0.f, 0.f, 0.f, 0.f}, a1 = a0;
#pragma unroll
        for (int i = 0; i < 8; ++i) { const int k = kq + 128 * i; const f32x4 w = __builtin_nontemporal_load((const f32x4*)(a.w_ada + (size_t)k * 3072 + c0 + 4 * cq)); a0 += a.c[k] * w; a1 += a.c[1024 + k] * w; }
#pragma unroll
        for (int o = 4; o < 64; o <<= 1)
#pragma unroll
            for (int e = 0; e < 4; ++e) { a0[e] += __shfl_xor(a0[e], o); a1[e] += __shfl_xor(a1[e], o); }
        LAS float* red = (LAS float*)(lds + MISC_OFF);
        if (lane < 4) {
#pragma unroll
            for (int e = 0; e < 4; ++e) { red[wid * 32 + lane * 4 + e] = a0[e]; red[wid * 32 + 16 + lane * 4 + e] = a1[e]; } }
        __syncthreads();
        if (tid < 32) { float s = 0.f;
#pragma unroll
            for (int w = 0; w < 8; ++w) s += red[w * 32 + tid];
            const int bb = tid >> 4, j = tid & 15; mod[bb * 3072 + c0 + j] = s + a.b_ada[c0 + j]; }
    }
    if (blk == G - 1 && wid == 0) {
        const float s1 = wave_sum(a.lq1[lane] * a.lk1[lane]), s2 = wave_sum(a.lq2[lane] * a.lk2[lane]);
        const float gq = wave_max(fabsf(a.qg[lane])), gk = wave_max(fabsf(a.kg[lane]));
        if (lane == 0) { mod[SC_LAM] = expf(s1) - expf(s2) + 0.2f; mod[SC_MB] = 8.0f * gq * gk * LOG2E; }
    }
    {
        LAS float* scr = (LAS float*)(lds + wid * 16384);
        const int gw = blk * 8 + wid, NGW = G * 8;
        constexpr int I_IN = (DM / 64) * (NIN / 32), I_OUT = (DM / 64) * (DM / 32);
        for (int it = gw; it < I_IN + I_OUT; it += NGW) {
            if (it < I_IN) transpose_item<true>(a.w_in, DM, NIN, WinT, scr, it, lane);
            else transpose_item<false>(a.w_out, DM, DM, WoutT, scr, it - I_IN, lane);
        }
    }
#endif
    f32x4 xa[4][4];
    { const int gw = blk * 8 + wid, NGW = G * 8;
#pragma unroll
      for (int u = 0; u < 4; ++u) { const int m = gw + u * NGW; const float* xr = a.x + (size_t)(m < MROWS ? m : 0) * DM;
#pragma unroll
          for (int j = 0; j < 4; ++j) xa[u][j] = __builtin_nontemporal_load((const f32x4*)(xr + 4 * lane + 256 * j)); } }
    xcd_barrier(bar);
#if PHM & 1
    {
        const int gw = blk * 8 + wid, NGW = G * 8;
#define P1_ROW(m_, v_) do { const int bb = (m_) >> 13; const float* sh = mod + bb * 3072; const float* sc = sh + 1024; float ss = 0.f; \
            _Pragma("unroll") for (int j = 0; j < 4; ++j) ss += (v_[j][0] * v_[j][0] + v_[j][1] * v_[j][1]) + (v_[j][2] * v_[j][2] + v_[j][3] * v_[j][3]); \
            const float rstd = 1.0f / sqrtf(wave_sum(ss) * (1.0f / DM) + EPS); \
            _Pragma("unroll") for (int j = 0; j < 4; ++j) { const int col = 4 * lane + 256 * j; const f32x4 g = *(const f32x4*)(a.norm_g + col), s1 = *(const f32x4*)(sc + col), s0 = *(const f32x4*)(sh + col); \
                const f32x4 hv = (v_[j] * rstd * g) * (1.0f + s1) + s0; \
                *(unsigned long long*)(XN + (size_t)(m_) * DM + col) = (unsigned long long)pk2(hv[0], hv[1]) | ((unsigned long long)pk2(hv[2], hv[3]) << 32); } } while (0)
        f32x4 xb[4][4];
#pragma unroll
        for (int u = 0; u < 4; ++u) { const int m = gw + (4 + u) * NGW; const float* xr = a.x + (size_t)(m < MROWS ? m : 0) * DM;
#pragma unroll
            for (int j = 0; j < 4; ++j) xb[u][j] = __builtin_nontemporal_load((const f32x4*)(xr + 4 * lane + 256 * j)); }
        asm volatile("" ::: "memory");
#pragma unroll
        for (int u = 0; u < 4; ++u) { const int m = gw + u * NGW; if (m < MROWS) P1_ROW(m, xa[u]); }
#pragma unroll
        for (int u = 0; u < 4; ++u) { const int m = gw + (4 + u) * NGW; if (m < MROWS) P1_ROW(m, xb[u]); }
        for (int m = gw + 8 * NGW; m < MROWS; m += NGW) {
            f32x4 v[4];
#pragma unroll
            for (int j = 0; j < 4; ++j) v[j] = *(const f32x4*)(a.x + (size_t)m * DM + 4 * lane + 256 * j);
            P1_ROW(m, v); }
#undef P1_ROW
    }
#endif
    xcd_barrier(bar);
    }
#if PHM & 2
    {
        pg8::Gemm g{XN, WinT, MROWS, NIN, DM}; pg8::StaticOrder S; S.init(MROWS, NIN, G, blk);
        pg8::EpiIn E{SBQ, SBK, SBG, DFQ, DFK, DFG, SBVT, DFVT, a.qg, a.kg};
#ifndef REP_G1
#define REP_G1 1
#endif
        pg8::gemm_phase<pg8::EpiIn, pg8::StaticOrder, true, true>(lds, g, S, E);
#if REP_G1 > 1
        pg8::gemm_phase<pg8::EpiIn, pg8::StaticOrder, true, true>(lds, g, S, E);
#endif
    }
#endif
    xcd_barrier(bar);
    {
        const float lam_u = __int_as_float(__builtin_amdgcn_readfirstlane(__float_as_int(mod[SC_LAM]))), Mb_u = __int_as_float(__builtin_amdgcn_readfirstlane(__float_as_int(mod[SC_MB])));
#ifndef REP_ATT
#define REP_ATT 1
#endif
        for (int rep = 0; rep < REP_ATT; ++rep) {
        if (rep) { xcd_barrier(bar); if (blk == 0 && tid < 8) __hip_atomic_store(barw + BAR_QCTR + 64 * tid, 0u, __ATOMIC_RELAXED, __HIP_MEMORY_SCOPE_AGENT); xcd_barrier(bar); }
        int myq = (int)(bar.x & 7u), tries = 0;
        for (;;) {
            int qo_ = LDSCTL_OFF + 64; asm volatile("" : "+s"(qo_)); volatile LAS int* qslot = (volatile LAS int*)(lds + qo_);
            int tq0_ = threadIdx.x; asm volatile("" : "+v"(tq0_));
            __syncthreads();
            if (tq0_ == 0) { int slot = -1;
                while (tries < 8) { int len = (myq < 4) ? 64 : 192;
#ifdef REP2_DF_ONLY
                    if (rep) len = 64;
#endif
#ifdef REP2_SB_ONLY
                    if (rep) { if (myq < 4) len = 0; }
#endif
 const int idx = (int)atomicAdd(barw + BAR_QCTR + 64 * myq, 1u);
#ifdef REP2_SB_ONLY
                    if (rep && myq >= 4 && idx < 64) continue;
#endif
                    if (idx < len) { slot = (myq << 16) | idx; break; } myq = (myq + 1) & 7; ++tries; }
                qslot[0] = slot; }
            __syncthreads();
            const int slot = qslot[0];
            if (slot < 0) break;
            const int q = slot >> 16, idx = slot & 0xffff;
            int ub, uh, uq; bool isdf = true;
            if (q < 4) { ub = q >> 1; uh = 3 - (q & 1); uq = 63 - idx; }
            else { const int y = q - 4;
                if (idx < 64) { ub = y >> 1; uh = 1 - (y & 1); uq = 63 - idx; }
                else { const int v = idx - 64; const int bh = 4 * y + (v & 3); ub = bh >> 3; uh = bh & 7; uq = 31 - (v >> 2); isdf = false; } }
            if (isdf) att::df_unit((LAS char*)lds, ub, uh, uq, DFQ, DFK, DFVT, DFG, MIX, lam_u, Mb_u, a.subg);
            else att::sb_unit((LAS char*)lds, ub, uh, uq, SBQ, SBK, SBVT, SBG, MIX);
        }
        }
    }
    xcd_barrier(bar);
#ifdef EXTRA_SYNCS
    for (int es = 0; es < EXTRA_SYNCS; ++es) xcd_barrier(bar);
#endif
#if PHM & 16
    {
        pg8::Gemm g{MIX, WoutT, MROWS, DM, DM}; pg8::StaticOrder S; S.init(MROWS, DM, G, blk);
        pg8::EpiOut E{a.x, mod, a.out};
#ifndef REP_G2
#define REP_G2 1
#endif
        pg8::gemm_phase<pg8::EpiOut, pg8::StaticOrder, true, true>(lds, g, S, E);
#if REP_G2 > 1
        pg8::gemm_phase<pg8::EpiOut, pg8::StaticOrder, true, true>(lds, g, S, E);
#endif
    }
#endif
}

extern "C" void kernel_launch(void* const* d_in, const int* in_sizes, int n_in, void* d_out, int out_size, void* d_ws, size_t ws_size, hipStream_t stream) {
    static int grid = 0;
    if (grid == 0) {
        int dev = 0, cus = 0, per_cu = 0;
        hipGetDevice(&dev); hipDeviceGetAttribute(&cus, hipDeviceAttributeMultiprocessorCount, dev);
        hipFuncSetAttribute((const void*)fwd_megakernel, hipFuncAttributeMaxDynamicSharedMemorySize, LDS_BYTES);
        hipOccupancyMaxActiveBlocksPerMultiprocessor(&per_cu, (const void*)fwd_megakernel, 512, LDS_BYTES);
        if (per_cu < 1) per_cu = 1;
        grid = cus * per_cu; (void)hipGetLastError();
        if (n_in != 14 || ws_size < WS_END) { fprintf(stderr, "kernel_launch: unexpected inputs (n_in %d, ws %zu)\n", n_in, ws_size); }
    }
    (void)hipMemsetAsync((char*)d_ws + WS_BAR, 0, BAR_ZERO_BYTES, stream);
    Args a{};
    a.x = (const float*)d_in[0]; a.c = (const float*)d_in[1]; a.norm_g = (const float*)d_in[2]; a.w_ada = (const float*)d_in[3]; a.b_ada = (const float*)d_in[4]; a.w_in = (const float*)d_in[5];
    a.qg = (const float*)d_in[6]; a.kg = (const float*)d_in[7]; a.lq1 = (const float*)d_in[8]; a.lk1 = (const float*)d_in[9]; a.lq2 = (const float*)d_in[10]; a.lk2 = (const float*)d_in[11];
    a.subg = (const float*)d_in[12]; a.w_out = (const float*)d_in[13]; a.out = (float*)d_out; a.ws = (unsigned char*)d_ws;
    void* args[] = {&a};
    hipError_t e = hipLaunchCooperativeKernel((const void*)fwd_megakernel, dim3(grid), dim3(512), args, LDS_BYTES, stream);
    if (e != hipSuccess) fprintf(stderr, "cooperative launch failed: %s (grid %d)\n", hipGetErrorString(e), grid);
}
```

```cpp
#include <hip/hip_runtime.h>
#include <hip/hip_cooperative_groups.h>
#include <cstdio>
#include <cstdint>
namespace cg = cooperative_groups;
namespace pg8 {
#define PG8_LAS __attribute__((address_space(3)))
typedef unsigned short bf16_t;
typedef short bf16x8 __attribute__((ext_vector_type(8)));
typedef float f32x4 __attribute__((ext_vector_type(4)));
typedef unsigned u32x4 __attribute__((ext_vector_type(4)));
constexpr int BM = 256, BK = 64, HALF = 128, HTB = HALF * BK * 2  , STAGE_BYTES = 8 * HTB, NXCD = 8, WGM = 8;

__host__ __device__ __forceinline__ int lds_byte(int r, int c) { const int st = (r >> 4) * 2 + (c >> 5), rr = r & 15, cc = c & 31, ob = rr * 64 + cc * 2; return st * 1024 + (ob ^ (((ob >> 9) & 1) << 5)); }
__host__ __device__ __forceinline__ void stage_rc(int b, int& R, int& C) { const int st = b / 1024, sb = b % 1024, swz = sb ^ (((sb >> 9) & 1) << 5); R = (st >> 1) * 16 + swz / 64; C = (st & 1) * 32 + (swz % 64) / 2; }
__host__ __device__ __forceinline__ int perm32(int rho) { const int n = rho >> 4, i = rho & 15; return 8 * (i >> 2) + 4 * n + (i & 3); }

struct Unit { int pm, pn; };
struct Gemm { const bf16_t* A; const bf16_t* Bt; int M, N, K; };

struct StaticOrder {
    int nM, nN, nwg, G, c;
    __host__ __device__ void init(int M, int N, int G_, int c_) { nM = M / BM; nN = N / BM; nwg = nM * nN; G = G_; c = c_; }
    __host__ __device__ bool next(int i, Unit& u) const {
        const long L = (long)i * G + c; if (L >= nwg) return false;
        int wgid = (int)L; { const int q = nwg / NXCD, r = nwg % NXCD, xcd = wgid % NXCD, off = wgid / NXCD; wgid = (xcd < r ? xcd * (q + 1) : r * (q + 1) + (xcd - r) * q) + off; }
        const int nig = WGM * nN, gid = wgid / nig, fm = gid * WGM, gsz = (nM - fm) < WGM ? (nM - fm) : WGM;
        u.pm = fm + ((wgid % nig) % gsz); u.pn = (wgid % nig) / gsz; return true;
    }
    __device__ __forceinline__ void a_ready(const Unit&) const {}
    __device__ __forceinline__ void done(const Unit&) const {}
};

__device__ __forceinline__ unsigned cvt_pk_bf16(float lo, float hi) { unsigned r; asm volatile("v_cvt_pk_bf16_f32 %0, %1, %2" : "=v"(r) : "v"(lo), "v"(hi)); return r; }
template <class Epi, class Sched, bool ALIGN_EPI = false, bool SP2 = false>
__device__ __forceinline__ void gemm_phase(PG8_LAS unsigned char* lds, const Gemm g, const Sched& S, const Epi& E) {
    int tid_ = threadIdx.x; asm volatile("" : "+v"(tid_));
    const int tid = tid_, wid = __builtin_amdgcn_readfirstlane(tid >> 6), lane = tid & 63, wr = wid >> 2, wc = wid & 3, fr = lane & 15, fq = lane >> 4;
    const int K = g.K, nt = K / BK;
    unsigned voffA[2], voffB[2];
#pragma unroll
    for (int i = 0; i < 2; ++i) { int R, C; stage_rc(tid * 16 + i * 8192, R, C); const int Rb = Epi::PERM ? ((R & ~31) + perm32(R & 31)) : R;
        voffA[i] = (unsigned)(R * K + C) * 2u; voffB[i] = (unsigned)(Rb * K + C) * 2u; }
    const size_t kstep = (size_t)(BK * 2);
    const size_t hstep = (size_t)HALF * K * 2;
    const size_t tstep = 2 * hstep;
    const unsigned ldsw = (unsigned)wid * 1024u;
    const int aoff = lds_byte(wr * 64 + fr, fq * 8), boff = lds_byte(wc * 32 + fr, fq * 8);
#define PG8_SA(b, h) (((b) * 2 + (h)) * HTB)
#define PG8_SB(b, h) ((4 + (b) * 2 + (h)) * HTB)
#define PG8_STAGE(bufoff, gbase, voff) do { _Pragma("unroll") for (int _i = 0; _i < 2; ++_i) \
        __builtin_amdgcn_global_load_lds((const unsigned*)((const char*)(gbase) + (voff)[_i]), (PG8_LAS unsigned*)(lds + (bufoff) + ldsw + _i * 8192), 16, 0, 0); } while (0)
#define PG8_LDA(dst, b, h) do { _Pragma("unroll") for (int m = 0; m < 4; ++m) _Pragma("unroll") for (int k = 0; k < 2; ++k) dst[m][k] = *(const PG8_LAS bf16x8*)(lds + PG8_SA(b, h) + aoff + m * 2048 + k * 1024); } while (0)
#define PG8_LDB(dst, b, h) do { _Pragma("unroll") for (int n = 0; n < 2; ++n) _Pragma("unroll") for (int k = 0; k < 2; ++k) dst[n][k] = *(const PG8_LAS bf16x8*)(lds + PG8_SB(b, h) + boff + n * 2048 + k * 1024); } while (0)
#define PG8_MMA(ai, bj, At, Bt) do { __builtin_amdgcn_s_setprio(1); _Pragma("unroll") for (int m = 0; m < 4; ++m) _Pragma("unroll") for (int n = 0; n < 2; ++n) _Pragma("unroll") for (int k = 0; k < 2; ++k) \
        acc[ai][bj][m][n] = __builtin_amdgcn_mfma_f32_16x16x32_bf16(Bt[n][k], At[m][k], acc[ai][bj][m][n], 0, 0, 0); __builtin_amdgcn_s_setprio(0); } while (0)
#define PG8_WAIT_V(n) asm volatile("s_waitcnt vmcnt(" #n ")" ::: "memory")
#define PG8_WAIT_L(n) asm volatile("s_waitcnt lgkmcnt(" #n ")" ::: "memory")
#define PG8_BAR __builtin_amdgcn_s_barrier()
#define PG8_SCHED __builtin_amdgcn_sched_barrier(0)
    Unit cur, nxt; int ui = 0;
    if (!S.next(0, cur)) return;
    f32x4 acc[2][2][4][2];
#pragma unroll
    for (int a = 0; a < 2; ++a)
#pragma unroll
        for (int b = 0; b < 2; ++b)
#pragma unroll
            for (int m = 0; m < 4; ++m)
#pragma unroll
                for (int n = 0; n < 2; ++n) acc[a][b][m][n] = (f32x4){0.f, 0.f, 0.f, 0.f};
    bf16x8 At[4][2], B0[2][2], B1[2][2];
    const char* cA = (const char*)g.A + (size_t)cur.pm * tstep; const char* cB = (const char*)g.Bt + (size_t)cur.pn * tstep;
    S.a_ready(cur);
    if constexpr (SP2) {
        PG8_STAGE(PG8_SB(0, 0), cB, voffB); PG8_STAGE(PG8_SB(0, 1), cB + hstep, voffB); PG8_STAGE(PG8_SA(0, 0), cA, voffA); PG8_STAGE(PG8_SA(0, 1), cA + hstep, voffA);
        if (wr == 1) PG8_BAR;
        PG8_WAIT_V(2); PG8_BAR;
        PG8_STAGE(PG8_SB(1, 0), cB + kstep, voffB); PG8_STAGE(PG8_SA(1, 0), cA + kstep, voffA); PG8_STAGE(PG8_SB(1, 1), cB + hstep + kstep, voffB);
        PG8_WAIT_V(6); PG8_BAR;
    } else {
        PG8_STAGE(PG8_SB(0, 0), cB, voffB); PG8_STAGE(PG8_SA(0, 0), cA, voffA); PG8_STAGE(PG8_SB(0, 1), cB + hstep, voffB); PG8_STAGE(PG8_SA(0, 1), cA + hstep, voffA);
        if (wr == 1) PG8_BAR;
        PG8_WAIT_V(4); PG8_BAR;
        PG8_STAGE(PG8_SB(1, 0), cB + kstep, voffB); PG8_STAGE(PG8_SA(1, 0), cA + kstep, voffA); PG8_STAGE(PG8_SB(1, 1), cB + hstep + kstep, voffB);
        PG8_WAIT_V(6); PG8_BAR;
    }
    for (;;) {
        const bool has_next = S.next(ui + 1, nxt);
        const char* nA = has_next ? (const char*)g.A + (size_t)nxt.pm * tstep : cA; const char* nB = has_next ? (const char*)g.Bt + (size_t)nxt.pn * tstep : cB;
        for (int t = 0; t < nt; t += 2) {
            const bool last = (t == nt - 2);
            const char* a1 = cA + (size_t)(t + 1) * kstep;
            const char* a2 = last ? nA : cA + (size_t)(t + 2) * kstep; const char* b2 = last ? nB : cB + (size_t)(t + 2) * kstep;
            const char* a3 = a2 + kstep; const char* b3 = b2 + kstep;
            if (last && has_next) S.a_ready(nxt);
            if constexpr (SP2) {
            PG8_LDB(B0, 0, 0); PG8_LDB(B1, 0, 1); PG8_SCHED; PG8_LDA(At, 0, 0); PG8_STAGE(PG8_SA(1, 1), a1 + hstep, voffA);
            PG8_WAIT_V(8); PG8_WAIT_L(0); PG8_BAR; PG8_MMA(0, 0, At, B0); PG8_MMA(0, 1, At, B1); PG8_BAR; PG8_SCHED;
            PG8_LDA(At, 0, 1); PG8_STAGE(PG8_SB(0, 0), b2, voffB); PG8_STAGE(PG8_SB(0, 1), b2 + hstep, voffB); PG8_STAGE(PG8_SA(0, 0), a2, voffA);
            PG8_WAIT_V(8); PG8_WAIT_L(0); PG8_BAR; PG8_MMA(1, 0, At, B0); PG8_MMA(1, 1, At, B1); PG8_BAR; PG8_SCHED;
            PG8_LDB(B0, 1, 0); PG8_LDB(B1, 1, 1); PG8_SCHED; PG8_LDA(At, 1, 0); PG8_STAGE(PG8_SA(0, 1), a2 + hstep, voffA);
            PG8_WAIT_V(8); PG8_WAIT_L(0); PG8_BAR; PG8_MMA(0, 0, At, B0); PG8_MMA(0, 1, At, B1); PG8_BAR; PG8_SCHED;
            PG8_LDA(At, 1, 1); PG8_STAGE(PG8_SB(1, 0), b3, voffB); PG8_STAGE(PG8_SB(1, 1), b3 + hstep, voffB); PG8_STAGE(PG8_SA(1, 0), a3, voffA);
            PG8_WAIT_V(8); PG8_WAIT_L(0); PG8_BAR; PG8_MMA(1, 0, At, B0); PG8_MMA(1, 1, At, B1); PG8_BAR; PG8_SCHED;
            } else {
            PG8_LDB(B0, 0, 0); PG8_SCHED; PG8_LDA(At, 0, 0); PG8_STAGE(PG8_SA(1, 1), a1 + hstep, voffA);
            PG8_WAIT_L(8); PG8_BAR; PG8_WAIT_L(0); PG8_MMA(0, 0, At, B0); PG8_BAR; PG8_SCHED;
            PG8_LDB(B1, 0, 1); PG8_STAGE(PG8_SB(0, 0), b2, voffB);
            PG8_BAR; PG8_WAIT_L(0); PG8_MMA(0, 1, At, B1); PG8_BAR;
            PG8_LDA(At, 0, 1); PG8_STAGE(PG8_SA(0, 0), a2, voffA);
            PG8_BAR; PG8_WAIT_L(0); PG8_MMA(1, 0, At, B0); PG8_BAR; PG8_SCHED;
            PG8_STAGE(PG8_SB(0, 1), b2 + hstep, voffB);
            PG8_WAIT_V(6); PG8_BAR; PG8_MMA(1, 1, At, B1); PG8_BAR;
            PG8_LDB(B0, 1, 0); PG8_SCHED; PG8_LDA(At, 1, 0); PG8_STAGE(PG8_SA(0, 1), a2 + hstep, voffA);
            PG8_WAIT_L(8); PG8_BAR; PG8_WAIT_L(0); PG8_MMA(0, 0, At, B0); PG8_BAR; PG8_SCHED;
            PG8_LDB(B1, 1, 1); PG8_STAGE(PG8_SB(1, 0), b3, voffB);
            PG8_BAR; PG8_WAIT_L(0); PG8_MMA(0, 1, At, B1); PG8_BAR;
            PG8_LDA(At, 1, 1); PG8_STAGE(PG8_SA(1, 0), a3, voffA);
            PG8_BAR; PG8_WAIT_L(0); PG8_MMA(1, 0, At, B0); PG8_BAR; PG8_SCHED;
            PG8_STAGE(PG8_SB(1, 1), b3 + hstep, voffB);
            PG8_WAIT_V(6); PG8_BAR; PG8_MMA(1, 1, At, B1); PG8_BAR;
            }
        }
        if constexpr (ALIGN_EPI) { if (wr == 0) PG8_BAR; }
        if constexpr (!Epi::AFTER_DRAIN) { E(acc, cur, wr, wc, fr, fq); S.done(cur); }
        if (!has_next) break;
#pragma unroll
        for (int a = 0; a < 2; ++a)
#pragma unroll
            for (int b = 0; b < 2; ++b)
#pragma unroll
                for (int m = 0; m < 4; ++m)
#pragma unroll
                    for (int n = 0; n < 2; ++n) acc[a][b][m][n] = (f32x4){0.f, 0.f, 0.f, 0.f};
        cur = nxt; cA = nA; cB = nB; ++ui;
        if constexpr (ALIGN_EPI) { if (wr == 1) PG8_BAR; }
    }
    PG8_WAIT_V(0);
    if constexpr (!ALIGN_EPI) { if (wr == 0) PG8_BAR; }
    PG8_BAR;
    if constexpr (Epi::AFTER_DRAIN) { E.fused(acc, cur, wr, wc, fr, fq, lds, wid, lane); S.done(cur); }
#undef PG8_SA
#undef PG8_SB
#undef PG8_STAGE
#undef PG8_LDA
#undef PG8_LDB
#undef PG8_MMA
#undef PG8_WAIT_V
#undef PG8_WAIT_L
#undef PG8_BAR
#undef PG8_SCHED
}
}

constexpr int BATCH = 2, SEQ = 8192, DM = 1024, MROWS = BATCH * SEQ, NIN = 4096;
constexpr float EPS = 1e-6f, LOG2E = 1.4426950408889634f, C2 = 0.125f * 1.4426950408889634f;
constexpr size_t MiB = 1u << 20;
constexpr size_t WS_MOD = 0, WS_WIN = 1 * MiB, WS_WOUT = 9 * MiB, WS_XN = 16 * MiB, WS_SBQ = 48 * MiB, WS_SBK = 64 * MiB, WS_SBG = 80 * MiB,
                 WS_DFQ = 96 * MiB, WS_DFK = 112 * MiB, WS_DFG = 128 * MiB, WS_SBVT = 144 * MiB, WS_DFVT = 160 * MiB, WS_MIX = 176 * MiB, WS_END = 208 * MiB;
constexpr int RING_BYTES = 131072, LDS_BYTES = 147456, MISC_OFF = RING_BYTES;
constexpr int SC_LAM = 6144, SC_MB = 6145;
constexpr size_t WS_BAR = 256 * 1024, BAR_ZERO_BYTES = 16384;
constexpr int BAR_QCTR = 3520;
constexpr int LDSCTL_OFF = MISC_OFF + 4096;
#define LAS __attribute__((address_space(3)))

namespace pg8 {
struct EpiIn {
    static constexpr bool PERM = true, AFTER_DRAIN = false;
    bf16_t *SBQ, *SBK, *SBG, *DFQ, *DFK, *DFG, *SBVT, *DFVT; const float *qg, *kg;
    __device__ __forceinline__ void operator()(const f32x4 (&acc)[2][2][4][2], const Unit& u, int wr, int wc, int fr, int fq) const {
        const int kind = u.pn >> 1;
        const int row0 = u.pm * BM + wr * 64 + fr;
        const int cl = (u.pn & 1) * 256 + wc * 64 + 8 * fq;
        if (kind == 2 || kind == 6) {
            bf16_t* VT = (kind == 2) ? SBVT : DFVT; const int dsh = (kind == 2) ? 6 : 7;
            const int pos = 8 * ((fr >> 2) & 1) + (fr & 3) + 4 * (fr >> 3);
#pragma unroll
            for (int ai = 0; ai < 2; ++ai)
#pragma unroll
                for (int m = 0; m < 4; ++m) {
                    const int row = row0 + ai * HALF + m * 16; const int b = row >> 13, t = row & 8191; const int tb = (t & 48) + pos; const int tT = t >> 6;
#pragma unroll
                    for (int bj = 0; bj < 2; ++bj)
#pragma unroll
                        for (int n = 0; n < 2; ++n)
#pragma unroll
                            for (int e = 0; e < 4; ++e) { const int col = cl + 32 * bj + 4 * n + e; const unsigned w = cvt_pk_bf16(acc[ai][bj][m][n][e], 0.f);
                                const int hh = col >> dsh, dd = col & ((1 << dsh) - 1);
                                VT[((size_t)(b * (512 >> dsh) + hh) * 128 + tT) * (size_t)(64 << dsh) + dd * 64 + tb] = (bf16_t)(w & 0xffffu); }
                }
            return;
        }
        bf16_t* O = kind == 0 ? SBQ : kind == 1 ? SBK : kind == 3 ? SBG : kind == 4 ? DFQ : kind == 5 ? DFK : DFG;
        f32x4 gv[2][2];
        if (kind == 4 || kind == 5) { const float* g = (kind == 4) ? qg : kg;
#pragma unroll
            for (int bj = 0; bj < 2; ++bj)
#pragma unroll
                for (int n = 0; n < 2; ++n) gv[bj][n] = *(const f32x4*)(g + 32 * bj + 8 * fq + 4 * n); }
#pragma unroll
        for (int ai = 0; ai < 2; ++ai)
#pragma unroll
            for (int m = 0; m < 4; ++m) {
                const int row = row0 + ai * HALF + m * 16;
                f32x4 v[2][2];
#pragma unroll
                for (int bj = 0; bj < 2; ++bj)
#pragma unroll
                    for (int n = 0; n < 2; ++n) v[bj][n] = acc[ai][bj][m][n];
                if (kind == 4 || kind == 5) {
                    float ss = 0.f;
#pragma unroll
                    for (int bj = 0; bj < 2; ++bj)
#pragma unroll
                        for (int n = 0; n < 2; ++n) { const f32x4 x = v[bj][n]; ss += (x[0] * x[0] + x[1] * x[1]) + (x[2] * x[2] + x[3] * x[3]); }
                    ss += __shfl_xor(ss, 16); ss += __shfl_xor(ss, 32);
                    float rs = 1.0f / sqrtf(ss * (1.0f / 64.0f) + 1e-6f); if (kind == 4) rs *= 0.125f * 1.4426950408889634f;
#pragma unroll
                    for (int bj = 0; bj < 2; ++bj)
#pragma unroll
                        for (int n = 0; n < 2; ++n) v[bj][n] = v[bj][n] * rs * gv[bj][n];
                } else if (kind == 0) {
#pragma unroll
                    for (int bj = 0; bj < 2; ++bj)
#pragma unroll
                        for (int n = 0; n < 2; ++n) v[bj][n] = v[bj][n] * (0.125f * 1.4426950408889634f);
                } else if (kind == 3 || kind == 7) {
#pragma unroll
                    for (int bj = 0; bj < 2; ++bj)
#pragma unroll
                        for (int n = 0; n < 2; ++n)
#pragma unroll
                            for (int e = 0; e < 4; ++e) { const float x = v[bj][n][e]; v[bj][n][e] = x * __builtin_amdgcn_rcpf(1.0f + __builtin_amdgcn_exp2f(-1.4426950408889634f * x)); }
                }
                bf16_t* rowp = O + (size_t)row * 512 + cl;
#pragma unroll
                for (int bj = 0; bj < 2; ++bj) { u32x4 w; w.x = cvt_pk_bf16(v[bj][0][0], v[bj][0][1]); w.y = cvt_pk_bf16(v[bj][0][2], v[bj][0][3]); w.z = cvt_pk_bf16(v[bj][1][0], v[bj][1][1]); w.w = cvt_pk_bf16(v[bj][1][2], v[bj][1][3]);
                    if (kind == 1 || kind == 5) *(u32x4*)(rowp + 32 * bj) = w; else __builtin_nontemporal_store(w, (u32x4*)(rowp + 32 * bj)); }
            }
    }
};
struct EpiOut {
    static constexpr bool PERM = true, AFTER_DRAIN = false;
    const float* x; const float* mod; float* out;
    __device__ __forceinline__ void operator()(const f32x4 (&acc)[2][2][4][2], const Unit& u, int wr, int wc, int fr, int fq) const {
        const int row0 = u.pm * BM + wr * 64 + fr, col0 = u.pn * BM + wc * 32 + 8 * fq; const int b = u.pm >> 5;
#pragma unroll
        for (int bj = 0; bj < 2; ++bj) { const int col = col0 + bj * HALF; const f32x4 g0 = *(const f32x4*)(mod + b * 3072 + 2048 + col), g1 = *(const f32x4*)(mod + b * 3072 + 2048 + col + 4);
#pragma unroll
            for (int ai = 0; ai < 2; ++ai)
#pragma unroll
                for (int m = 0; m < 4; ++m) { const size_t off = (size_t)(row0 + ai * HALF + m * 16) * 1024 + col; const f32x4 x0 = __builtin_nontemporal_load((const f32x4*)(x + off)), x1 = __builtin_nontemporal_load((const f32x4*)(x + off + 4));
                    __builtin_nontemporal_store(x0 + g0 * acc[ai][bj][m][0], (f32x4*)(out + off)); __builtin_nontemporal_store(x1 + g1 * acc[ai][bj][m][1], (f32x4*)(out + off + 4)); } }
    }
};
}

namespace att {
typedef unsigned short bf16_t;
typedef short bf16x8 __attribute__((ext_vector_type(8)));
typedef float f32x16 __attribute__((ext_vector_type(16)));
typedef float f32x4 __attribute__((ext_vector_type(4)));
typedef float f32x2 __attribute__((ext_vector_type(2)));
typedef __bf16 bf16x2 __attribute__((ext_vector_type(2)));
typedef unsigned u32x4 __attribute__((ext_vector_type(4)));
typedef unsigned u32x2 __attribute__((ext_vector_type(2)));
#define MFMA32(a, b, c) __builtin_amdgcn_mfma_f32_32x32x16_bf16((a), (b), (c), 0, 0, 0)
#define DI __device__ __forceinline__
#define FENCE() do { asm volatile("" ::: "memory"); __builtin_amdgcn_sched_barrier(0); } while (0)
DI unsigned cvtpk(float lo, float hi) { f32x2 v = {lo, hi}; bf16x2 b = __builtin_convertvector(v, bf16x2); return __builtin_bit_cast(unsigned, b); }
DI float bf_lo(unsigned w) { return __uint_as_float(w << 16); }
DI float bf_hi(unsigned w) { return __uint_as_float(w & 0xffff0000u); }
DI int crow(int r, int hi) { return (r & 3) + 8 * (r >> 2) + 4 * hi; }
DI float ex2(float x) { return __builtin_amdgcn_exp2f(x); }
DI float lg2(float x) { return __builtin_amdgcn_logf(x); }
template <int S> DI bf16x8 pack8(const f32x16& x) { u32x4 p; p[0] = cvtpk(x[8 * S], x[8 * S + 1]); p[1] = cvtpk(x[8 * S + 2], x[8 * S + 3]); p[2] = cvtpk(x[8 * S + 4], x[8 * S + 5]); p[3] = cvtpk(x[8 * S + 6], x[8 * S + 7]); return __builtin_bit_cast(bf16x8, p); }
template <int S> DI void pack8_hl(const f32x16& x, bf16x8& h, bf16x8& l) { u32x4 p, q;
#pragma unroll
    for (int i = 0; i < 4; ++i) { const float a = x[8 * S + 2 * i], b = x[8 * S + 2 * i + 1]; const unsigned w = cvtpk(a, b); p[i] = w; q[i] = cvtpk(a - bf_lo(w), b - bf_hi(w)); }
    h = __builtin_bit_cast(bf16x8, p); l = __builtin_bit_cast(bf16x8, q); }
DI int off128(int row, int c) { return row * 128 + ((c ^ ((row >> 1) & 7)) << 4); }
DI int off256(int row, int c) { return row * 256 + ((c ^ (row & 15)) << 4); }
DI bf16x8 ldsv(const LAS char* p) { return *(const LAS bf16x8*)p; }
DI f32x16 splat16(float v) { f32x16 r;
#pragma unroll
    for (int i = 0; i < 16; ++i) r[i] = v;
    return r; }

DI void swz_in(u32x4 t, u32x2& g0, u32x2& g1) { auto r0 = __builtin_amdgcn_permlane32_swap(t.x, t.z, false, false); auto r1 = __builtin_amdgcn_permlane32_swap(t.y, t.w, false, false); g0.x = r0[0]; g0.y = r1[0]; g1.x = r0[1]; g1.y = r1[1]; }
DI u32x4 swz_out(u32x2 w0, u32x2 w1) { auto r0 = __builtin_amdgcn_permlane32_swap(w0.x, w1.x, false, false); auto r1 = __builtin_amdgcn_permlane32_swap(w0.y, w1.y, false, false); u32x4 o; o.x = r0[0]; o.y = r1[0]; o.z = r0[1]; o.w = r1[1]; return o; }
DI void glds16(const void* gsrc, unsigned lds_dst) { unsigned keep;
    asm volatile("s_mov_b32 %0, m0\n\ts_mov_b32 m0, %2\n\ts_nop 0\n\tglobal_load_lds_dwordx4 %1, off\n\ts_mov_b32 m0, %0" : "=&s"(keep) : "v"(gsrc), "s"(lds_dst) : "memory"); }
#define WAIT_BAR0() asm volatile("s_waitcnt vmcnt(0) lgkmcnt(0)\n\ts_barrier" ::: "memory")
#define WAIT_BAR1() asm volatile("s_waitcnt vmcnt(1) lgkmcnt(0)\n\ts_barrier" ::: "memory")
#define WAIT_BAR4() asm volatile("s_waitcnt vmcnt(4) lgkmcnt(0)\n\ts_barrier" ::: "memory")
#define RFL(x) ((unsigned)__builtin_amdgcn_readfirstlane((int)(x)))

DI void sb_unit(LAS char* lds, int b, int h, int qb, const bf16_t* __restrict__ Q, const bf16_t* __restrict__ K, const bf16_t* __restrict__ VT, const bf16_t* __restrict__ G, bf16_t* __restrict__ MIX) {
    int tid_ = threadIdx.x; asm volatile("" : "+v"(tid_));
    const int tid = tid_, lane = tid & 63, r32 = lane & 31, hi = lane >> 5; const int wid = __builtin_amdgcn_readfirstlane(tid >> 6);
    const int q0 = qb * 256, qw0 = q0 + 32 * wid, tq = qw0 + r32;
    volatile LAS int* flags = (volatile LAS int*)(lds + MISC_OFF);
    const unsigned lds0 = (unsigned)(uintptr_t)lds;
    bf16x8 qf[4];
#pragma unroll
    for (int d0 = 0; d0 < 4; ++d0) qf[d0] = __builtin_nontemporal_load((const bf16x8*)(Q + (size_t)(b * SEQ + tq) * 512 + h * 64 + d0 * 16 + hi * 8));
    bf16x8 tp0, tp1, ones;
#pragma unroll
    for (int j = 0; j < 8; ++j) { const int kvk = 8 * (j >> 2) + 4 * hi + (j & 3); tp0[j] = (kvk > r32) ? (short)0x3F80 : (short)0; tp1[j] = (16 + kvk > r32) ? (short)0x3F80 : (short)0; ones[j] = (short)0x3F80; }
    const int drow = 8 * wid + (lane >> 3), dch = (lane & 7) ^ ((drow >> 1) & 7);
    const bf16_t* ksrc = K + (size_t)(b * SEQ + drow) * 512 + h * 64 + dch * 8;
    const bf16_t* vsrc = VT + (size_t)(b * 8 + h) * (SEQ * 64) + drow * 64 + dch * 8;
#define SB_DMA(T, st) do { const unsigned base_ = lds0 + (st) * 16384 + wid * 1024; glds16(ksrc + (size_t)(T) * 64 * 512, RFL(base_)); glds16(vsrc + (size_t)(T) * 4096, RFL(base_ + 8192)); } while (0)
    f32x16 o0 = splat16(0.f), o1 = splat16(0.f); float carry = 0.f; int done = 0;
    const int nt = (q0 + 256) / 64;
    WAIT_BAR0();
    SB_DMA(nt - 1, 0);
    for (int T = nt - 1, it = 0; T >= 0; --T, ++it) {
        WAIT_BAR0();
        if (it > 0) { volatile LAS int* fl = flags + ((it & 1) ^ 1) * 8; const int all = fl[0] & fl[1] & fl[2] & fl[3] & fl[4] & fl[5] & fl[6] & fl[7]; if (all) break; }
        if (T > 0) SB_DMA(T - 1, (it + 1) & 1);
        const LAS char* Kt = lds + (it & 1) * 16384; const LAS char* Vt = Kt + 8192;
        const int kv0 = 64 * T;
        if (kv0 < qw0 + 31 && !done) {
            f32x16 p0 = splat16(0.f), p1 = splat16(0.f);
#pragma unroll
            for (int d0 = 0; d0 < 4; ++d0) { const bf16x8 k0 = ldsv(Kt + off128(r32, 2 * d0 + hi)), k1 = ldsv(Kt + off128(32 + r32, 2 * d0 + hi)); p0 = MFMA32(k0, qf[d0], p0); p1 = MFMA32(k1, qf[d0], p1); }
            const bool diag = (kv0 + 63 >= qw0);
            f32x16 L0, L1;
#pragma unroll
            for (int r = 0; r < 16; ++r) {
                { const float z = p0[r]; const float lg = (z > 30.f) ? z : lg2(1.0f + ex2(z)); const bool valid = !diag || (kv0 + crow(r, hi) < tq); L0[r] = valid ? -lg : 0.f; p0[r] = valid ? (z - lg) : -1e30f; }
                { const float z = p1[r]; const float lg = (z > 30.f) ? z : lg2(1.0f + ex2(z)); const bool valid = !diag || (kv0 + 32 + crow(r, hi) < tq); L1[r] = valid ? -lg : 0.f; p1[r] = valid ? (z - lg) : -1e30f; }
            }
            const bf16x8 Lh0 = pack8<0>(L0), Lh1 = pack8<1>(L0), Lh2 = pack8<0>(L1), Lh3 = pack8<1>(L1);
            f32x16 C0 = splat16(carry), C1 = C0;
            C0 = MFMA32(tp0, Lh0, C0); C0 = MFMA32(tp1, Lh1, C0); C0 = MFMA32(ones, Lh2, C0); C0 = MFMA32(ones, Lh3, C0);
            C1 = MFMA32(tp0, Lh2, C1); C1 = MFMA32(tp1, Lh3, C1);
            const float cn = C0[0] + L0[0];
            carry = __shfl(cn, r32, 64);
#pragma unroll
            for (int r = 0; r < 16; ++r) { p0[r] = ex2(p0[r] + C0[r]); p1[r] = ex2(p1[r] + C1[r]); }
            const bf16x8 pa0 = pack8<0>(p0), pa1 = pack8<1>(p0), pa2 = pack8<0>(p1), pa3 = pack8<1>(p1);
#define SB_PV(ks, pa) { const bf16x8 v0 = ldsv(Vt + off128(r32, 2 * (ks) + hi)), v1 = ldsv(Vt + off128(32 + r32, 2 * (ks) + hi)); o0 = MFMA32(v0, pa, o0); o1 = MFMA32(v1, pa, o1); }
            SB_PV(0, pa0) SB_PV(1, pa1) SB_PV(2, pa2) SB_PV(3, pa3)
#undef SB_PV
            done = __all(carry < -152.f) ? 1 : 0;
        }
        if (lane == 0) flags[(it & 1) * 8 + wid] = done;
    }
#undef SB_DMA
    const size_t trow = (size_t)(b * SEQ + tq);
#pragma unroll
    for (int db = 0; db < 2; ++db)
#pragma unroll
        for (int gp = 0; gp < 2; ++gp) { const int dc = 32 * db + 16 * gp + 8 * hi; const f32x16& o = db ? o1 : o0;
            u32x2 g0, g1; swz_in(__builtin_nontemporal_load((const u32x4*)(G + trow * 512 + h * 64 + dc)), g0, g1);
            u32x2 w0, w1; const int r0 = 8 * gp, r1 = 8 * gp + 4;
            w0.x = cvtpk(o[r0] * bf_lo(g0.x), o[r0 + 1] * bf_hi(g0.x)); w0.y = cvtpk(o[r0 + 2] * bf_lo(g0.y), o[r0 + 3] * bf_hi(g0.y));
            w1.x = cvtpk(o[r1] * bf_lo(g1.x), o[r1 + 1] * bf_hi(g1.x)); w1.y = cvtpk(o[r1 + 2] * bf_lo(g1.y), o[r1 + 3] * bf_hi(g1.y));
            *(u32x4*)(MIX + trow * 1024 + h * 64 + dc) = swz_out(w0, w1); }
}

struct DfCtx { int kad[4], vad[4]; bf16x8 qf[4]; float c0, sl; int tq, qw0, hi; };
#define PIN4(x) asm volatile("" : "+v"(x[0]), "+v"(x[1]), "+v"(x[2]), "+v"(x[3]))
#define MEMFENCE() asm volatile("" ::: "memory")
DI void df_scores(const LAS char* Kst, const DfCtx& c, f32x16& p, f32x16& q, int kv0) {
    const float bb = c.c0 + c.sl * (float)kv0;
    bf16x8 k0[4], k1[4];
#pragma unroll
    for (int d0 = 0; d0 < 4; ++d0) k0[d0] = ldsv(Kst + c.kad[d0]);
    MEMFENCE();
#pragma unroll
    for (int r = 0; r < 16; ++r) p[r] = __builtin_fmaf(c.sl, (float)((r & 3) + 8 * (r >> 2)), bb);
    PIN4(k0);
#pragma unroll
    for (int d0 = 0; d0 < 4; ++d0) p = MFMA32(k0[d0], c.qf[d0], p);
#pragma unroll
    for (int d0 = 0; d0 < 4; ++d0) k1[d0] = ldsv(Kst + c.kad[d0] + 8192);
    MEMFENCE();
    { const float ba = bb + c.sl * 32.0f;
#pragma unroll
      for (int r = 0; r < 16; ++r) q[r] = __builtin_fmaf(c.sl, (float)((r & 3) + 8 * (r >> 2)), ba); }
    PIN4(k1);
#pragma unroll
    for (int d0 = 0; d0 < 4; ++d0) q = MFMA32(k1[d0], c.qf[d0], q);
}
template <bool PV> DI void df_pv_exp(const LAS char* Vst, const DfCtx& c, const bf16x8 (&pw)[4], f32x16 (&O)[4], f32x16& p, f32x16& q, bf16x8 (&pwN)[4], float& l, bool dg, int kv0) {
    bf16x8 v0[4];
    if (PV) {
#pragma unroll
        for (int ks = 0; ks < 4; ++ks) v0[ks] = ldsv(Vst + c.vad[ks]);
        MEMFENCE(); }
#pragma unroll
    for (int r = 0; r < 16; ++r) p[r] = ex2(p[r]);
    if (PV) {
        PIN4(v0);
#pragma unroll
        for (int ks = 0; ks < 4; ++ks) O[0] = MFMA32(v0[ks], pw[ks], O[0]);
#pragma unroll
        for (int ks = 0; ks < 4; ++ks) v0[ks] = ldsv(Vst + c.vad[ks] + 4096);
        MEMFENCE(); }
#pragma unroll
    for (int r = 0; r < 16; ++r) q[r] = ex2(q[r]);
    if (PV) {
        PIN4(v0);
#pragma unroll
        for (int ks = 0; ks < 4; ++ks) O[1] = MFMA32(v0[ks], pw[ks], O[1]);
#pragma unroll
        for (int ks = 0; ks < 4; ++ks) v0[ks] = ldsv(Vst + c.vad[ks] + 8192);
        MEMFENCE(); }
    if (dg) { const int lim = c.tq - kv0 - 4 * c.hi;
#pragma unroll
        for (int r = 0; r < 16; ++r) { if ((r & 3) + 8 * (r >> 2) > lim) p[r] = 0.f; if (32 + (r & 3) + 8 * (r >> 2) > lim) q[r] = 0.f; } }
    float ls = 0.f;
#pragma unroll
    for (int r = 0; r < 16; ++r) ls += p[r] + q[r];
    l += ls;
    if (PV) {
        PIN4(v0);
#pragma unroll
        for (int ks = 0; ks < 4; ++ks) O[2] = MFMA32(v0[ks], pw[ks], O[2]);
#pragma unroll
        for (int ks = 0; ks < 4; ++ks) v0[ks] = ldsv(Vst + c.vad[ks] + 12288);
        MEMFENCE(); }
    pwN[0] = pack8<0>(p); pwN[1] = pack8<1>(p); pwN[2] = pack8<0>(q); pwN[3] = pack8<1>(q);
    if (PV) {
        PIN4(v0);
#pragma unroll
        for (int ks = 0; ks < 4; ++ks) O[3] = MFMA32(v0[ks], pw[ks], O[3]);
    }
}
constexpr int DF_KR = 0, DF_VR = 65536;
DI void df_unit(LAS char* lds, int b, int h, int qb, const bf16_t* __restrict__ Q, const bf16_t* __restrict__ K, const bf16_t* __restrict__ VT, const bf16_t* __restrict__ G, bf16_t* __restrict__ MIX,
                float lam, float Mb  , const float* __restrict__ subg) {
    int tid_ = threadIdx.x; asm volatile("" : "+v"(tid_));
    const int tid = tid_, lane = tid & 63, r32 = lane & 31, hi = lane >> 5; const int wid = __builtin_amdgcn_readfirstlane(tid >> 6);
    const int mp = wid >> 2, wq = wid & 3;
    const int q0 = qb * 128, qw0 = q0 + 32 * wq, tq = qw0 + r32;
    LAS float* Xch = (LAS float*)lds;
    const unsigned lds0 = (unsigned)(uintptr_t)lds;
    DfCtx c; c.qw0 = qw0; c.tq = 0; c.hi = 0;
#pragma unroll
    for (int d0 = 0; d0 < 4; ++d0) c.qf[d0] = __builtin_nontemporal_load((const bf16x8*)(Q + (size_t)(b * SEQ + tq) * 512 + h * 128 + mp * 64 + d0 * 16 + hi * 8));
    { const int kx = hi ^ (r32 & 15), vx = hi ^ ((r32 >> 1) & 7);
#pragma unroll
      for (int i = 0; i < 4; ++i) { c.kad[i] = r32 * 256 + (((8 * mp + 2 * i) ^ kx) << 4); c.vad[i] = r32 * 128 + (((2 * i) ^ vx) << 4); } }
    const int krow = 4 * wid + (lane >> 4), kch = (lane & 15) ^ (krow & 15);
    const int vrow = 8 * wid + (lane >> 3), vch = (lane & 7) ^ ((vrow >> 1) & 7);
    const bf16_t* ksrc = K + (size_t)(b * SEQ + krow) * 512 + h * 128 + kch * 8;
    const bf16_t* vsrc = VT + (size_t)(b * 4 + h) * (SEQ * 128) + vrow * 64 + vch * 8;
#define DF_DMA(T, ko_, vo_) do { const unsigned kb_ = lds0 + DF_KR + (ko_) + wid * 1024, vb_ = lds0 + DF_VR + (vo_) + wid * 1024; const bf16_t* kp_ = ksrc + (size_t)(T) * 64 * 512; const bf16_t* vp_ = vsrc + (size_t)(T) * 8192; \
        glds16(kp_, RFL(kb_)); glds16(kp_ + 32 * 512, RFL(kb_ + 8192)); glds16(vp_, RFL(vb_)); glds16(vp_ + 4096, RFL(vb_ + 8192)); } while (0)
    f32x16 O[4];
#pragma unroll
    for (int i = 0; i < 4; ++i) O[i] = splat16(0.f);
    float l = 0.f;
    const float slope2 = ex2(-2.0f * (float)(h + 1)) * LOG2E;
    c.sl = slope2; c.c0 = -slope2 * (float)(tq - 4 * hi) - Mb;
    const int nt = (q0 + 128) / 64;
    int T0 = 0; { float mb2 = Mb; asm volatile("" : "+s"(mb2)); const int W = (int)ceilf((150.0f + 2.0f * mb2) / slope2) + 1; const int x = q0 - 63 - W; if (x >= 0) T0 = x / 64 + 1; }
    WAIT_BAR0();
    DF_DMA(T0, 0, 0); if (T0 + 1 < nt) DF_DMA(T0 + 1, 16384, 16384);
    bf16x8 pw[4], pwN[4]; f32x16 p, q;
#define DF_HEAD(so_, T) do { if ((T) + 1 < nt) WAIT_BAR4(); else WAIT_BAR0(); if ((T) + 2 < nt) DF_DMA((T) + 2, ((so_) + 32768) & 65535, ((so_) + 32768) & 65535); } while (0)
#define DF_ROT() do { _Pragma("unroll") for (int i = 0; i < 4; ++i) pw[i] = pwN[i]; } while (0)
    c.tq = tq; c.hi = hi;
    DF_HEAD(0, T0); df_scores(lds + DF_KR, c, p, q, 64 * T0); df_pv_exp<false>(lds + DF_VR, c, pw, O, p, q, pwN, l, T0 >= nt - 2, 64 * T0); DF_ROT();
    bool havep = true;
#define DF_MAIN(so_, T) do { DF_HEAD(so_, T); df_scores(lds + DF_KR + (so_), c, p, q, 64 * (T)); df_pv_exp<true>(lds + DF_VR + (((so_) + 49152) & 65535), c, pw, O, p, q, pwN, l, false, 64 * (T)); DF_ROT(); } while (0)
    int T = T0 + 1;
    for (; T + 4 <= nt - 2; T += 4) { DF_MAIN(16384, T); DF_MAIN(32768, T + 1); DF_MAIN(49152, T + 2); DF_MAIN(0, T + 3); }
    int so = 16384;
    { int tt_ = threadIdx.x; asm volatile("" : "+v"(tt_)); c.tq = q0 + 32 * wq + (tt_ & 31); c.hi = (tt_ & 63) >> 5; }
#pragma unroll 1
    for (; T < nt; ++T) {
        DF_HEAD(so, T);
        const bool dg = T >= nt - 2; const int kv0 = 64 * T; const int vpo = (so + 49152) & 65535;
        if (!(dg && kv0 > qw0 + 31)) { df_scores(lds + DF_KR + so, c, p, q, kv0); df_pv_exp<true>(lds + DF_VR + vpo, c, pw, O, p, q, pwN, l, dg, kv0); DF_ROT(); }
        else { if (havep) {
#pragma unroll
                for (int db = 0; db < 4; ++db)
#pragma unroll
                    for (int ks = 0; ks < 4; ++ks) O[db] = MFMA32(ldsv(lds + DF_VR + vpo + c.vad[ks] + db * 4096), pw[ks], O[db]); }
               havep = false; }
        so = (so + 16384) & 65535;
    }
    const int vprev = ((nt - 1 - T0) & 3) * 16384;
#undef DF_HEAD
#undef DF_ROT
#undef DF_MAIN
    if (havep) {
#pragma unroll
        for (int db = 0; db < 4; ++db)
#pragma unroll
            for (int ks = 0; ks < 4; ++ks) O[db] = MFMA32(ldsv(lds + DF_VR + vprev + c.vad[ks] + db * 4096), pw[ks], O[db]); }
#undef DF_DMA
    int te_ = threadIdx.x; asm volatile("" : "+v"(te_));
    const int lane2 = te_ & 63, hi2 = lane2 >> 5, tq2 = q0 + 32 * wq + (lane2 & 31);
    l += __shfl_xor(l, 32);
    WAIT_BAR0();
    if (mp == 1) { const float i2 = lam / l;
#pragma unroll
        for (int db = 0; db < 4; ++db)
#pragma unroll
            for (int r = 0; r < 16; ++r) Xch[(wq * 64 + db * 16 + r) * 64 + lane2] = O[db][r] * i2; }
    WAIT_BAR0();
    if (mp == 0) {
        const float i1 = 1.0f / l; float ss = 0.f;
#pragma unroll
        for (int db = 0; db < 4; ++db)
            {
#pragma unroll
              for (int r = 0; r < 16; ++r) { const float v = O[db][r] * i1 - Xch[(wq * 64 + db * 16 + r) * 64 + lane2]; O[db][r] = v; ss += v * v; } asm volatile("" : "+v"(O[db]), "+v"(ss) :: "memory"); }
        ss += __shfl_xor(ss, 32);
        const float rs = 0.8f / sqrtf(ss * (1.0f / 128.0f) + EPS);
        const size_t trow = (size_t)(b * SEQ + tq2);
#pragma unroll
        for (int db = 0; db < 4; ++db)
#pragma unroll
            for (int gp = 0; gp < 2; ++gp) { const int dc = 32 * db + 16 * gp + 8 * hi2, d0 = 32 * db + 16 * gp + 4 * hi2, d1 = d0 + 8; const int r0 = 8 * gp, r1 = 8 * gp + 4;
                u32x2 g0, g1; swz_in(__builtin_nontemporal_load((const u32x4*)(G + trow * 512 + h * 128 + dc)), g0, g1);
                const f32x4 s0 = *(const f32x4*)(subg + d0), s1 = *(const f32x4*)(subg + d1);
                u32x2 w0, w1;
                w0.x = cvtpk(O[db][r0] * rs * s0[0] * bf_lo(g0.x), O[db][r0 + 1] * rs * s0[1] * bf_hi(g0.x)); w0.y = cvtpk(O[db][r0 + 2] * rs * s0[2] * bf_lo(g0.y), O[db][r0 + 3] * rs * s0[3] * bf_hi(g0.y));
                w1.x = cvtpk(O[db][r1] * rs * s1[0] * bf_lo(g1.x), O[db][r1 + 1] * rs * s1[1] * bf_hi(g1.x)); w1.y = cvtpk(O[db][r1 + 2] * rs * s1[2] * bf_lo(g1.y), O[db][r1 + 3] * rs * s1[3] * bf_hi(g1.y));
                *(u32x4*)(MIX + trow * 1024 + 512 + h * 128 + dc) = swz_out(w0, w1); asm volatile("" ::: "memory"); }
    }
}
}

typedef unsigned short bf16;
typedef unsigned v4u __attribute__((ext_vector_type(4)));
typedef float f32x4 __attribute__((ext_vector_type(4)));
__device__ __forceinline__ unsigned f2bf(float f) { unsigned u = __builtin_bit_cast(unsigned, f); return (u + 0x7fffu + ((u >> 16) & 1u)) >> 16; }
__device__ __forceinline__ unsigned pk2(float lo, float hi) { return f2bf(lo) | (f2bf(hi) << 16); }
__device__ __forceinline__ float wave_sum(float v) {
#pragma unroll
    for (int o = 1; o < 64; o <<= 1) v += __shfl_xor(v, o);
    return v; }
__device__ __forceinline__ float wave_max(float v) {
#pragma unroll
    for (int o = 1; o < 64; o <<= 1) v = fmaxf(v, __shfl_xor(v, o));
    return v; }
template <bool PERMROWS> __device__ __forceinline__ void transpose_item(const float* W, int K, int N, bf16* WT, LAS float* scr, int item, int lane) {
    const int nblk = N / 32, kb = item / nblk, nb = item % nblk, k0 = 64 * kb, n0 = 32 * nb;
    float tv[32];
#pragma unroll
    for (int i = 0; i < 32; ++i) tv[i] = __builtin_nontemporal_load(W + (size_t)(k0 + 2 * i + (lane >> 5)) * N + n0 + (lane & 31));
#pragma unroll
    for (int i = 0; i < 32; ++i) scr[(2 * i + (lane >> 5)) * 33 + (lane & 31)] = tv[i];
    asm volatile("s_waitcnt lgkmcnt(0)" ::: "memory");
    int r0 = n0;
    if (PERMROWS) { const int L0 = n0 & 255; r0 = (n0 & ~255) + 128 * ((L0 >> 5) & 1) + 32 * (L0 >> 6); }
    const int c = lane & 7;
#pragma unroll
    for (int j = 0; j < 4; ++j) { const int n = (lane >> 3) + 8 * j; const LAS float* s = scr + (8 * c) * 33 + n;
        v4u o; o.x = pk2(s[0 * 33], s[1 * 33]); o.y = pk2(s[2 * 33], s[3 * 33]); o.z = pk2(s[4 * 33], s[5 * 33]); o.w = pk2(s[6 * 33], s[7 * 33]);
        *(v4u*)(WT + (size_t)(r0 + n) * K + k0 + 8 * c) = o; }
    asm volatile("s_waitcnt lgkmcnt(0)" ::: "memory");
}

#define XB_TMO      128
#define XB_XCNT(j)  (256  + 64 * (j))
#define XB_XSUB(j)  (1280 + 64 * (j))
#define XB_XGEN(j)  (2304 + 64 * (j))
#define XB_TOP      3328
#define XB_TOPGEN   3392
#define XCD_BAR_WORDS 3456
#define XB_SPIN_CAP (1u << 18)

__device__ __forceinline__ unsigned xb_ld(unsigned* p)              { return __hip_atomic_load(p, __ATOMIC_RELAXED, __HIP_MEMORY_SCOPE_AGENT); }
__device__ __forceinline__ unsigned xb_add(unsigned* p, unsigned v) { return __hip_atomic_fetch_add(p, v, __ATOMIC_RELAXED, __HIP_MEMORY_SCOPE_AGENT); }
__device__ __forceinline__ unsigned xb_xcc_id() { return (unsigned)__builtin_amdgcn_s_getreg((3 << 11) | 20) & 0xFu; }
#define XB_SPIN(cond, bar) do { unsigned _sp = 0; while (cond) { __builtin_amdgcn_s_sleep(1); \
    if ((++_sp & 255u) == 0u) { if (xb_ld(&(bar)[XB_TMO])) break; if (_sp > XB_SPIN_CAP) { atomicAdd(&(bar)[XB_TMO], 1u); break; } } } } while (0)

struct XcdBarrier {
    unsigned* bar; unsigned x;
    volatile LAS unsigned* st;
};

__device__ __forceinline__ XcdBarrier xcd_barrier_post(unsigned* bar, volatile LAS unsigned* st) {
    XcdBarrier b; b.bar = bar; b.x = xb_xcc_id(); b.st = st;
    if (threadIdx.x == 0) (void)xb_add(&bar[XB_XCNT(b.x)], 1u);
    return b;
}
__device__ __forceinline__ void xcd_barrier_complete(unsigned* bar, unsigned x, unsigned& nloc, unsigned& nx) {
    const unsigned G = gridDim.x * gridDim.y * gridDim.z;
    unsigned sum, cnt, mine, sp = 0u;
    for (;;) {
        sum = 0u; cnt = 0u; mine = 0u;
#pragma unroll
        for (unsigned j = 0; j < 16; ++j) { const unsigned c = xb_ld(&bar[XB_XCNT(j)]); sum += c; cnt += (c > 0u) ? 1u : 0u; mine = (j == x) ? c : mine; }
        if (sum == G) break;
        __builtin_amdgcn_s_sleep(1);
        if ((++sp & 255u) == 0u) { if (xb_ld(&bar[XB_TMO])) break; if (sp > XB_SPIN_CAP) { atomicAdd(&bar[XB_TMO], 1u); break; } }
    }
    nloc = mine > 0u ? mine : 1u; nx = cnt > 0u ? cnt : 1u;
}

__device__ __forceinline__ void xcd_barrier(const XcdBarrier& b) {
    asm volatile("s_waitcnt vmcnt(0)" ::: "memory");
    __syncthreads();
    if (threadIdx.x == 0) {
        unsigned* bar = b.bar;
        __builtin_amdgcn_s_waitcnt(0);
        unsigned nloc = b.st[0], nx = b.st[1];
        if (nloc == 0u) { xcd_barrier_complete(bar, b.x, nloc, nx); b.st[0] = nloc; b.st[1] = nx; }
        const unsigned old = xb_add(&bar[XB_XSUB(b.x)], 1u);
        const unsigned gen = old / nloc;
        if (old + 1u == (gen + 1u) * nloc) {
            __builtin_amdgcn_fence(__ATOMIC_RELEASE, "agent");
            asm volatile("s_waitcnt vmcnt(0)" ::: "memory");
            const unsigned og = xb_add(&bar[XB_TOP], 1u);
            const unsigned tg = og / nx;
            if (og + 1u == (tg + 1u) * nx) xb_add(&bar[XB_TOPGEN], 1u);
            else XB_SPIN(xb_ld(&bar[XB_TOPGEN]) == tg, bar);
            __builtin_amdgcn_fence(__ATOMIC_ACQUIRE, "agent");
            xb_add(&bar[XB_XGEN(b.x)], 1u);
            asm volatile("s_waitcnt vmcnt(0)" ::: "memory");
        } else {
            XB_SPIN(xb_ld(&bar[XB_XGEN(b.x)]) == gen, bar);
            __builtin_amdgcn_fence(__ATOMIC_ACQUIRE, "agent");
            asm volatile("s_waitcnt vmcnt(0)" ::: "memory");
        }
    }
    __syncthreads();
}

struct Args { const float *x, *c, *norm_g, *w_ada, *b_ada, *w_in, *qg, *kg, *lq1, *lk1, *lq2, *lk2, *subg, *w_out; float* out; unsigned char* ws; };

__global__ void __launch_bounds__(512) fwd_megakernel(Args a) {
    extern __shared__ __attribute__((aligned(16))) unsigned char lds_raw[];
    cg::grid_group grid = cg::this_grid();
    LAS unsigned char* lds = (LAS unsigned char*)lds_raw;
    const int tid = threadIdx.x, lane = tid & 63; const int wid = __builtin_amdgcn_readfirstlane(tid >> 6);
    const int blk = blockIdx.x, G = gridDim.x;
    unsigned char* ws = a.ws;
    float* mod = (float*)(ws + WS_MOD);
    unsigned* barw = (unsigned*)(ws + WS_BAR);
    volatile LAS unsigned* bst = (volatile LAS unsigned*)(lds + LDSCTL_OFF);
    if (tid < 16) bst[tid] = 0u;
    __syncthreads();
    XcdBarrier bar = xcd_barrier_post(barw, bst);
    if (wid == 7) { const unsigned pfd = (unsigned)__builtin_amdgcn_readfirstlane((int)((unsigned)(uintptr_t)lds + MISC_OFF + 8192 + 7 * 1024));
#pragma unroll
        for (int k = 0; k < 2; ++k) { const int pg = 64 * k + lane; att::glds16((const char*)ws + (size_t)(pg < 104 ? pg : 103) * (2u << 20), pfd); }
        { const int pg = lane & 31; att::glds16((lane < 32 ? (const char*)a.out : (const char*)a.x) + (size_t)pg * (2u << 20), pfd); } }
    if (a.ws == nullptr) grid.sync();
    bf16* WinT = (bf16*)(ws + WS_WIN); bf16* WoutT = (bf16*)(ws + WS_WOUT); bf16* XN = (bf16*)(ws + WS_XN);
    bf16* SBQ = (bf16*)(ws + WS_SBQ); bf16* SBK = (bf16*)(ws + WS_SBK); bf16* SBG = (bf16*)(ws + WS_SBG);
    bf16* DFQ = (bf16*)(ws + WS_DFQ); bf16* DFK = (bf16*)(ws + WS_DFK); bf16* DFG = (bf16*)(ws + WS_DFG);
    bf16* SBVT = (bf16*)(ws + WS_SBVT); bf16* DFVT = (bf16*)(ws + WS_DFVT); bf16* MIX = (bf16*)(ws + WS_MIX);

#ifndef PHM
#define PHM 31
#endif
#ifndef REP_P01
#define REP_P01 1
#endif
    for (int rep01 = 0; rep01 < REP_P01; ++rep01) {
#if PHM & 1
    if (blk < 192) {
        const int c0 = 16 * blk, cq = tid & 3, kq = tid >> 2;
        f32x4 a0 = {0.f, 0.f, 0.f, 0.f}, a1 = a0;
#pragma unroll
        for (int i = 0; i < 8; ++i) { const int k = kq + 128 * i; const f32x4 w = __builtin_nontemporal_load((const f32x4*)(a.w_ada + (size_t)k * 3072 + c0 + 4 * cq)); a0 += a.c[k] * w; a1 += a.c[1024 + k] * w; }
#pragma unroll
        for (int o = 4; o < 64; o <<= 1)
#pragma unroll
            for (int e = 0; e < 4; ++e) { a0[e] += __shfl_xor(a0[e], o); a1[e] += __shfl_xor(a1[e], o); }
        LAS float* red = (LAS float*)(lds + MISC_OFF);
        if (lane < 4) {
#pragma unroll
            for (int e = 0; e < 4; ++e) { red[wid * 32 + lane * 4 + e] = a0[e]; red[wid * 32 + 16 + lane * 4 + e] = a1[e]; } }
        __syncthreads();
        if (tid < 32) { float s = 0.f;
#pragma unroll
            for (int w = 0; w < 8; ++w) s += red[w * 32 + tid];
            const int bb = tid >> 4, j = tid & 15; mod[bb * 3072 + c0 + j] = s + a.b_ada[c0 + j]; }
    }
    if (blk == G - 1 && wid == 0) {
        const float s1 = wave_sum(a.lq1[lane] * a.lk1[lane]), s2 = wave_sum(a.lq2[lane] * a.lk2[lane]);
        const float gq = wave_max(fabsf(a.qg[lane])), gk = wave_max(fabsf(a.kg[lane]));
        if (lane == 0) { mod[SC_LAM] = expf(s1) - expf(s2) + 0.2f; mod[SC_MB] = 8.0f * gq * gk * LOG2E; }
    }
    {
        LAS float* scr = (LAS float*)(lds + wid * 16384);
        const int gw = blk * 8 + wid, NGW = G * 8;
        constexpr int I_IN = (DM / 64) * (NIN / 32), I_OUT = (DM / 64) * (DM / 32);
        for (int it = gw; it < I_IN + I_OUT; it += NGW) {
            if (it < I_IN) transpose_item<true>(a.w_in, DM, NIN, WinT, scr, it, lane);
            else transpose_item<false>(a.w_out, DM, DM, WoutT, scr, it - I_IN, lane);
        }
    }
#endif
    f32x4 xa[4][4];
    { const int gw = blk * 8 + wid, NGW = G * 8;
#pragma unroll
      for (int u = 0; u < 4; ++u) { const int m = gw + u * NGW; const float* xr = a.x + (size_t)(m < MROWS ? m : 0) * DM;
#pragma unroll
          for (int j = 0; j < 4; ++j) xa[u][j] = __builtin_nontemporal_load((const f32x4*)(xr + 4 * lane + 256 * j)); } }
    xcd_barrier(bar);
#if PHM & 1
    {
        const int gw = blk * 8 + wid, NGW = G * 8;
#define P1_ROW(m_, v_) do { const int bb = (m_) >> 13; const float* sh = mod + bb * 3072; const float* sc = sh + 1024; float ss = 0.f; \
            _Pragma("unroll") for (int j = 0; j < 4; ++j) ss += (v_[j][0] * v_[j][0] + v_[j][1] * v_[j][1]) + (v_[j][2] * v_[j][2] + v_[j][3] * v_[j][3]); \
            const float rstd = 1.0f / sqrtf(wave_sum(ss) * (1.0f / DM) + EPS); \
            _Pragma("unroll") for (int j = 0; j < 4; ++j) { const int col = 4 * lane + 256 * j; const f32x4 g = *(const f32x4*)(a.norm_g + col), s1 = *(const f32x4*)(sc + col), s0 = *(const f32x4*)(sh + col); \
                const f32x4 hv = (v_[j] * rstd * g) * (1.0f + s1) + s0; \
                *(unsigned long long*)(XN + (size_t)(m_) * DM + col) = (unsigned long long)pk2(hv[0], hv[1]) | ((unsigned long long)pk2(hv[2], hv[3]) << 32); } } while (0)
        f32x4 xb[4][4];
#pragma unroll
        for (int u = 0; u < 4; ++u) { const int m = gw + (4 + u) * NGW; const float* xr = a.x + (size_t)(m < MROWS ? m : 0) * DM;
#pragma unroll
            for (int j = 0; j < 4; ++j) xb[u][j] = __builtin_nontemporal_load((const f32x4*)(xr + 4 * lane + 256 * j)); }
        asm volatile("" ::: "memory");
#pragma unroll
        for (int u = 0; u < 4; ++u) { const int m = gw + u * NGW; if (m < MROWS) P1_ROW(m, xa[u]); }
#pragma unroll
        for (int u = 0; u < 4; ++u) { const int m = gw + (4 + u) * NGW; if (m < MROWS) P1_ROW(m, xb[u]); }
        for (int m = gw + 8 * NGW; m < MROWS; m += NGW) {
            f32x4 v[4];
#pragma unroll
            for (int j = 0; j < 4; ++j) v[j] = *(const f32x4*)(a.x + (size_t)m * DM + 4 * lane + 256 * j);
            P1_ROW(m, v); }
#undef P1_ROW
    }
#endif
    xcd_barrier(bar);
    }
#if PHM & 2
    {
        pg8::Gemm g{XN, WinT, MROWS, NIN, DM}; pg8::StaticOrder S; S.init(MROWS, NIN, G, blk);
        pg8::EpiIn E{SBQ, SBK, SBG, DFQ, DFK, DFG, SBVT, DFVT, a.qg, a.kg};
#ifndef REP_G1
#define REP_G1 1
#endif
        pg8::gemm_phase<pg8::EpiIn, pg8::StaticOrder, true, true>(lds, g, S, E);
#if REP_G1 > 1
        pg8::gemm_phase<pg8::EpiIn, pg8::StaticOrder, true, true>(lds, g, S, E);
#endif
    }
#endif
    xcd_barrier(bar);
    {
        const float lam_u = __int_as_float(__builtin_amdgcn_readfirstlane(__float_as_int(mod[SC_LAM]))), Mb_u = __int_as_float(__builtin_amdgcn_readfirstlane(__float_as_int(mod[SC_MB])));
#ifndef REP_ATT
#define REP_ATT 1
#endif
        for (int rep = 0; rep < REP_ATT; ++rep) {
        if (rep) { xcd_barrier(bar); if (blk == 0 && tid < 8) __hip_atomic_store(barw + BAR_QCTR + 64 * tid, 0u, __ATOMIC_RELAXED, __HIP_MEMORY_SCOPE_AGENT); xcd_barrier(bar); }
        int myq = (int)(bar.x & 7u), tries = 0;
        for (;;) {
            int qo_ = LDSCTL_OFF + 64; asm volatile("" : "+s"(qo_)); volatile LAS int* qslot = (volatile LAS int*)(lds + qo_);
            int tq0_ = threadIdx.x; asm volatile("" : "+v"(tq0_));
            __syncthreads();
            if (tq0_ == 0) { int slot = -1;
                while (tries < 8) { int len = (myq < 4) ? 64 : 192;
#ifdef REP2_DF_ONLY
                    if (rep) len = 64;
#endif
#ifdef REP2_SB_ONLY
                    if (rep) { if (myq < 4) len = 0; }
#endif
 const int idx = (int)atomicAdd(barw + BAR_QCTR + 64 * myq, 1u);
#ifdef REP2_SB_ONLY
                    if (rep && myq >= 4 && idx < 64) continue;
#endif
                    if (idx < len) { slot = (myq << 16) | idx; break; } myq = (myq + 1) & 7; ++tries; }
                qslot[0] = slot; }
            __syncthreads();
            const int slot = qslot[0];
            if (slot < 0) break;
            const int q = slot >> 16, idx = slot & 0xffff;
            int ub, uh, uq; bool isdf = true;
            if (q < 4) { ub = q >> 1; uh = 3 - (q & 1); uq = 63 - idx; }
            else { const int y = q - 4;
                if (idx < 64) { ub = y >> 1; uh = 1 - (y & 1); uq = 63 - idx; }
                else { const int v = idx - 64; const int bh = 4 * y + (v & 3); ub = bh >> 3; uh = bh & 7; uq = 31 - (v >> 2); isdf = false; } }
            if (isdf) att::df_unit((LAS char*)lds, ub, uh, uq, DFQ, DFK, DFVT, DFG, MIX, lam_u, Mb_u, a.subg);
            else att::sb_unit((LAS char*)lds, ub, uh, uq, SBQ, SBK, SBVT, SBG, MIX);
        }
        }
    }
    xcd_barrier(bar);
#ifdef EXTRA_SYNCS
    for (int es = 0; es < EXTRA_SYNCS; ++es) xcd_barrier(bar);
#endif
#if PHM & 16
    {
        pg8::Gemm g{MIX, WoutT, MROWS, DM, DM}; pg8::StaticOrder S; S.init(MROWS, DM, G, blk);
        pg8::EpiOut E{a.x, mod, a.out};
#ifndef REP_G2
#define REP_G2 1
#endif
        pg8::gemm_phase<pg8::EpiOut, pg8::StaticOrder, false, true>(lds, g, S, E);
#if REP_G2 > 1
        pg8::gemm_phase<pg8::EpiOut, pg8::StaticOrder, false, true>(lds, g, S, E);
#endif
    }
#endif
}

extern "C" void kernel_launch(void* const* d_in, const int* in_sizes, int n_in, void* d_out, int out_size, void* d_ws, size_t ws_size, hipStream_t stream) {
    static int grid = 0;
    if (grid == 0) {
        int dev = 0, cus = 0, per_cu = 0;
        hipGetDevice(&dev); hipDeviceGetAttribute(&cus, hipDeviceAttributeMultiprocessorCount, dev);
        hipFuncSetAttribute((const void*)fwd_megakernel, hipFuncAttributeMaxDynamicSharedMemorySize, LDS_BYTES);
        hipOccupancyMaxActiveBlocksPerMultiprocessor(&per_cu, (const void*)fwd_megakernel, 512, LDS_BYTES);
        if (per_cu < 1) per_cu = 1;
        grid = cus * per_cu; (void)hipGetLastError();
        if (n_in != 14 || ws_size < WS_END) { fprintf(stderr, "kernel_launch: unexpected inputs (n_in %d, ws %zu)\n", n_in, ws_size); }
    }
    (void)hipMemsetAsync((char*)d_ws + WS_BAR, 0, BAR_ZERO_BYTES, stream);
    Args a{};
    a.x = (const float*)d_in[0]; a.c = (const float*)d_in[1]; a.norm_g = (const float*)d_in[2]; a.w_ada = (const float*)d_in[3]; a.b_ada = (const float*)d_in[4]; a.w_in = (const float*)d_in[5];
    a.qg = (const float*)d_in[6]; a.kg = (const float*)d_in[7]; a.lq1 = (const float*)d_in[8]; a.lk1 = (const float*)d_in[9]; a.lq2 = (const float*)d_in[10]; a.lk2 = (const float*)d_in[11];
    a.subg = (const float*)d_in[12]; a.w_out = (const float*)d_in[13]; a.out = (float*)d_out; a.ws = (unsigned char*)d_ws;
    void* args[] = {&a};
    hipError_t e = hipLaunchCooperativeKernel((const void*)fwd_megakernel, dim3(grid), dim3(512), args, LDS_BYTES, stream);
    if (e != hipSuccess) fprintf(stderr, "cooperative launch failed: %s (grid %d)\n", hipGetErrorString(e), grid);
}
```

```cpp
#include <hip/hip_runtime.h>
#include <hip/hip_cooperative_groups.h>
#include <cstdio>
#include <cstdint>
namespace cg = cooperative_groups;
namespace pg8 {
#define PG8_LAS __attribute__((address_space(3)))
typedef unsigned short bf16_t;
typedef short bf16x8 __attribute__((ext_vector_type(8)));
typedef float f32x4 __attribute__((ext_vector_type(4)));
typedef unsigned u32x4 __attribute__((ext_vector_type(4)));
constexpr int BM = 256, BK = 64, HALF = 128, HTB = HALF * BK * 2  , STAGE_BYTES = 8 * HTB, NXCD = 8, WGM = 8;

__host__ __device__ __forceinline__ int lds_byte(int r, int c) { const int st = (r >> 4) * 2 + (c >> 5), rr = r & 15, cc = c & 31, ob = rr * 64 + cc * 2; return st * 1024 + (ob ^ (((ob >> 9) & 1) << 5)); }
__host__ __device__ __forceinline__ void stage_rc(int b, int& R, int& C) { const int st = b / 1024, sb = b % 1024, swz = sb ^ (((sb >> 9) & 1) << 5); R = (st >> 1) * 16 + swz / 64; C = (st & 1) * 32 + (swz % 64) / 2; }
__host__ __device__ __forceinline__ int perm32(int rho) { const int n = rho >> 4, i = rho & 15; return 8 * (i >> 2) + 4 * n + (i & 3); }

struct Unit { int pm, pn; };
struct Gemm { const bf16_t* A; const bf16_t* Bt; int M, N, K; };

struct StaticOrder {
    int nM, nN, nwg, G, c;
    __host__ __device__ void init(int M, int N, int G_, int c_) { nM = M / BM; nN = N / BM; nwg = nM * nN; G = G_; c = c_; }
    __host__ __device__ bool next(int i, Unit& u) const {
        const long L = (long)i * G + c; if (L >= nwg) return false;
        int wgid = (int)L; { const int q = nwg / NXCD, r = nwg % NXCD, xcd = wgid % NXCD, off = wgid / NXCD; wgid = (xcd < r ? xcd * (q + 1) : r * (q + 1) + (xcd - r) * q) + off; }
        const int nig = WGM * nN, gid = wgid / nig, fm = gid * WGM, gsz = (nM - fm) < WGM ? (nM - fm) : WGM;
        u.pm = fm + ((wgid % nig) % gsz); u.pn = (wgid % nig) / gsz; return true;
    }
    __device__ __forceinline__ void a_ready(const Unit&) const {}
    __device__ __forceinline__ void done(const Unit&) const {}
};

__device__ __forceinline__ unsigned cvt_pk_bf16(float lo, float hi) { unsigned r; asm volatile("v_cvt_pk_bf16_f32 %0, %1, %2" : "=v"(r) : "v"(lo), "v"(hi)); return r; }
template <class Epi, class Sched, bool ALIGN_EPI = false, bool SP2 = false>
__device__ __forceinline__ void gemm_phase(PG8_LAS unsigned char* lds, const Gemm g, const Sched& S, const Epi& E) {
    int tid_ = threadIdx.x; asm volatile("" : "+v"(tid_));
    const int tid = tid_, wid = __builtin_amdgcn_readfirstlane(tid >> 6), lane = tid & 63, wr = wid >> 2, wc = wid & 3, fr = lane & 15, fq = lane >> 4;
    const int K = g.K, nt = K / BK;
    unsigned voffA[2], voffB[2];
#pragma unroll
    for (int i = 0; i < 2; ++i) { int R, C; stage_rc(tid * 16 + i * 8192, R, C); const int Rb = Epi::PERM ? ((R & ~31) + perm32(R & 31)) : R;
        voffA[i] = (unsigned)(R * K + C) * 2u; voffB[i] = (unsigned)(Rb * K + C) * 2u; }
    const size_t kstep = (size_t)(BK * 2);
    const size_t hstep = (size_t)HALF * K * 2;
    const size_t tstep = 2 * hstep;
    const unsigned ldsw = (unsigned)wid * 1024u;
    const int aoff = lds_byte(wr * 64 + fr, fq * 8), boff = lds_byte(wc * 32 + fr, fq * 8);
#define PG8_SA(b, h) (((b) * 2 + (h)) * HTB)
#define PG8_SB(b, h) ((4 + (b) * 2 + (h)) * HTB)
#define PG8_STAGE(bufoff, gbase, voff) do { _Pragma("unroll") for (int _i = 0; _i < 2; ++_i) \
        __builtin_amdgcn_global_load_lds((const unsigned*)((const char*)(gbase) + (voff)[_i]), (PG8_LAS unsigned*)(lds + (bufoff) + ldsw + _i * 8192), 16, 0, 0); } while (0)
#define PG8_LDA(dst, b, h) do { _Pragma("unroll") for (int m = 0; m < 4; ++m) _Pragma("unroll") for (int k = 0; k < 2; ++k) dst[m][k] = *(const PG8_LAS bf16x8*)(lds + PG8_SA(b, h) + aoff + m * 2048 + k * 1024); } while (0)
#define PG8_LDB(dst, b, h) do { _Pragma("unroll") for (int n = 0; n < 2; ++n) _Pragma("unroll") for (int k = 0; k < 2; ++k) dst[n][k] = *(const PG8_LAS bf16x8*)(lds + PG8_SB(b, h) + boff + n * 2048 + k * 1024); } while (0)
#define PG8_MMA(ai, bj, At, Bt) do { __builtin_amdgcn_s_setprio(1); _Pragma("unroll") for (int m = 0; m < 4; ++m) _Pragma("unroll") for (int n = 0; n < 2; ++n) _Pragma("unroll") for (int k = 0; k < 2; ++k) \
        acc[ai][bj][m][n] = __builtin_amdgcn_mfma_f32_16x16x32_bf16(Bt[n][k], At[m][k], acc[ai][bj][m][n], 0, 0, 0); __builtin_amdgcn_s_setprio(0); } while (0)
#define PG8_WAIT_V(n) asm volatile("s_waitcnt vmcnt(" #n ")" ::: "memory")
#define PG8_WAIT_L(n) asm volatile("s_waitcnt lgkmcnt(" #n ")" ::: "memory")
#define PG8_BAR __builtin_amdgcn_s_barrier()
#define PG8_SCHED __builtin_amdgcn_sched_barrier(0)
    Unit cur, nxt; int ui = 0;
    if (!S.next(0, cur)) return;
    f32x4 acc[2][2][4][2];
#pragma unroll
    for (int a = 0; a < 2; ++a)
#pragma unroll
        for (int b = 0; b < 2; ++b)
#pragma unroll
            for (int m = 0; m < 4; ++m)
#pragma unroll
                for (int n = 0; n < 2; ++n) acc[a][b][m][n] = (f32x4){0.f, 0.f, 0.f, 0.f};
    bf16x8 At[4][2], B0[2][2], B1[2][2];
    const char* cA = (const char*)g.A + (size_t)cur.pm * tstep; const char* cB = (const char*)g.Bt + (size_t)cur.pn * tstep;
    S.a_ready(cur);
    if constexpr (SP2) {
        PG8_STAGE(PG8_SB(0, 0), cB, voffB); PG8_STAGE(PG8_SB(0, 1), cB + hstep, voffB); PG8_STAGE(PG8_SA(0, 0), cA, voffA); PG8_STAGE(PG8_SA(0, 1), cA + hstep, voffA);
        if (wr == 1) PG8_BAR;
        PG8_WAIT_V(2); PG8_BAR;
        PG8_STAGE(PG8_SB(1, 0), cB + kstep, voffB); PG8_STAGE(PG8_SA(1, 0), cA + kstep, voffA); PG8_STAGE(PG8_SB(1, 1), cB + hstep + kstep, voffB);
        PG8_WAIT_V(6); PG8_BAR;
    } else {
        PG8_STAGE(PG8_SB(0, 0), cB, voffB); PG8_STAGE(PG8_SA(0, 0), cA, voffA); PG8_STAGE(PG8_SB(0, 1), cB + hstep, voffB); PG8_STAGE(PG8_SA(0, 1), cA + hstep, voffA);
        if (wr == 1) PG8_BAR;
        PG8_WAIT_V(4); PG8_BAR;
        PG8_STAGE(PG8_SB(1, 0), cB + kstep, voffB); PG8_STAGE(PG8_SA(1, 0), cA + kstep, voffA); PG8_STAGE(PG8_SB(1, 1), cB + hstep + kstep, voffB);
        PG8_WAIT_V(6); PG8_BAR;
    }
    for (;;) {
        const bool has_next = S.next(ui + 1, nxt);
        const char* nA = has_next ? (const char*)g.A + (size_t)nxt.pm * tstep : cA; const char* nB = has_next ? (const char*)g.Bt + (size_t)nxt.pn * tstep : cB;
        for (int t = 0; t < nt; t += 2) {
            const bool last = (t == nt - 2);
            const char* a1 = cA + (size_t)(t + 1) * kstep;
            const char* a2 = last ? nA : cA + (size_t)(t + 2) * kstep; const char* b2 = last ? nB : cB + (size_t)(t + 2) * kstep;
            const char* a3 = a2 + kstep; const char* b3 = b2 + kstep;
            if (last && has_next) S.a_ready(nxt);
            if constexpr (SP2) {
            PG8_LDB(B0, 0, 0); PG8_LDB(B1, 0, 1); PG8_SCHED; PG8_LDA(At, 0, 0); PG8_STAGE(PG8_SA(1, 1), a1 + hstep, voffA);
            PG8_WAIT_V(8); PG8_WAIT_L(0); PG8_BAR; PG8_MMA(0, 0, At, B0); PG8_MMA(0, 1, At, B1); PG8_BAR; PG8_SCHED;
            PG8_LDA(At, 0, 1); PG8_STAGE(PG8_SB(0, 0), b2, voffB); PG8_STAGE(PG8_SB(0, 1), b2 + hstep, voffB); PG8_STAGE(PG8_SA(0, 0), a2, voffA);
            PG8_WAIT_V(8); PG8_WAIT_L(0); PG8_BAR; PG8_MMA(1, 0, At, B0); PG8_MMA(1, 1, At, B1); PG8_BAR; PG8_SCHED;
            PG8_LDB(B0, 1, 0); PG8_LDB(B1, 1, 1); PG8_SCHED; PG8_LDA(At, 1, 0); PG8_STAGE(PG8_SA(0, 1), a2 + hstep, voffA);
            PG8_WAIT_V(8); PG8_WAIT_L(0); PG8_BAR; PG8_MMA(0, 0, At, B0); PG8_MMA(0, 1, At, B1); PG8_BAR; PG8_SCHED;
            PG8_LDA(At, 1, 1); PG8_STAGE(PG8_SB(1, 0), b3, voffB); PG8_STAGE(PG8_SB(1, 1), b3 + hstep, voffB); PG8_STAGE(PG8_SA(1, 0), a3, voffA);
            PG8_WAIT_V(8); PG8_WAIT_L(0); PG8_BAR; PG8_MMA(1, 0, At, B0); PG8_MMA(1, 1, At, B1); PG8_BAR; PG8_SCHED;
            } else {
            PG8_LDB(B0, 0, 0); PG8_SCHED; PG8_LDA(At, 0, 0); PG8_STAGE(PG8_SA(1, 1), a1 + hstep, voffA);
            PG8_WAIT_L(8); PG8_BAR; PG8_WAIT_L(0); PG8_MMA(0, 0, At, B0); PG8_BAR; PG8_SCHED;
            PG8_LDB(B1, 0, 1); PG8_STAGE(PG8_SB(0, 0), b2, voffB);
            PG8_BAR; PG8_WAIT_L(0); PG8_MMA(0, 1, At, B1); PG8_BAR;
            PG8_LDA(At, 0, 1); PG8_STAGE(PG8_SA(0, 0), a2, voffA);
            PG8_BAR; PG8_WAIT_L(0); PG8_MMA(1, 0, At, B0); PG8_BAR; PG8_SCHED;
            PG8_STAGE(PG8_SB(0, 1), b2 + hstep, voffB);
            PG8_WAIT_V(6); PG8_BAR; PG8_MMA(1, 1, At, B1); PG8_BAR;
            PG8_LDB(B0, 1, 0); PG8_SCHED; PG8_LDA(At, 1, 0); PG8_STAGE(PG8_SA(0, 1), a2 + hstep, voffA);
            PG8_WAIT_L(8); PG8_BAR; PG8_WAIT_L(0); PG8_MMA(0, 0, At, B0); PG8_BAR; PG8_SCHED;
            PG8_LDB(B1, 1, 1); PG8_STAGE(PG8_SB(1, 0), b3, voffB);
            PG8_BAR; PG8_WAIT_L(0); PG8_MMA(0, 1, At, B1); PG8_BAR;
            PG8_LDA(At, 1, 1); PG8_STAGE(PG8_SA(1, 0), a3, voffA);
            PG8_BAR; PG8_WAIT_L(0); PG8_MMA(1, 0, At, B0); PG8_BAR; PG8_SCHED;
            PG8_STAGE(PG8_SB(1, 1), b3 + hstep, voffB);
            PG8_WAIT_V(6); PG8_BAR; PG8_MMA(1, 1, At, B1); PG8_BAR;
            }
        }
        if constexpr (ALIGN_EPI) { if (wr == 0) PG8_BAR; }
        if constexpr (!Epi::AFTER_DRAIN) { E(acc, cur, wr, wc, fr, fq); S.done(cur); }
        if (!has_next) break;
#pragma unroll
        for (int a = 0; a < 2; ++a)
#pragma unroll
            for (int b = 0; b < 2; ++b)
#pragma unroll
                for (int m = 0; m < 4; ++m)
#pragma unroll
                    for (int n = 0; n < 2; ++n) acc[a][b][m][n] = (f32x4){0.f, 0.f, 0.f, 0.f};
        cur = nxt; cA = nA; cB = nB; ++ui;
        if constexpr (ALIGN_EPI) { if (wr == 1) PG8_BAR; }
    }
    PG8_WAIT_V(0);
    if constexpr (!ALIGN_EPI) { if (wr == 0) PG8_BAR; }
    PG8_BAR;
    if constexpr (Epi::AFTER_DRAIN) { E.fused(acc, cur, wr, wc, fr, fq, lds, wid, lane); S.done(cur); }
#undef PG8_SA
#undef PG8_SB
#undef PG8_STAGE
#undef PG8_LDA
#undef PG8_LDB
#undef PG8_MMA
#undef PG8_WAIT_V
#undef PG8_WAIT_L
#undef PG8_BAR
#undef PG8_SCHED
}
}

constexpr int BATCH = 2, SEQ = 8192, DM = 1024, MROWS = BATCH * SEQ, NIN = 4096;
constexpr float EPS = 1e-6f, LOG2E = 1.4426950408889634f, C2 = 0.125f * 1.4426950408889634f;
constexpr size_t MiB = 1u << 20;
constexpr size_t WS_MOD = 0, WS_WIN = 1 * MiB, WS_WOUT = 9 * MiB, WS_XN = 16 * MiB, WS_SBQ = 48 * MiB, WS_SBK = 64 * MiB, WS_SBG = 80 * MiB,
                 WS_DFQ = 96 * MiB, WS_DFK = 112 * MiB, WS_DFG = 128 * MiB, WS_SBVT = 144 * MiB, WS_DFVT = 160 * MiB, WS_MIX = 176 * MiB, WS_END = 208 * MiB;
constexpr int RING_BYTES = 131072, LDS_BYTES = 147456, MISC_OFF = RING_BYTES;
constexpr int SC_LAM = 6144, SC_MB = 6145;
constexpr size_t WS_BAR = 256 * 1024, BAR_ZERO_BYTES = 16384;
constexpr int BAR_QCTR = 3520;
constexpr int LDSCTL_OFF = MISC_OFF + 4096;
#define LAS __attribute__((address_space(3)))

namespace pg8 {
struct EpiIn {
    static constexpr bool PERM = true, AFTER_DRAIN = false;
    bf16_t *SBQ, *SBK, *SBG, *DFQ, *DFK, *DFG, *SBVT, *DFVT; const float *qg, *kg;
    __device__ __forceinline__ void operator()(const f32x4 (&acc)[2][2][4][2], const Unit& u, int wr, int wc, int fr, int fq) const {
        const int kind = u.pn >> 1;
        const int row0 = u.pm * BM + wr * 64 + fr;
        const int cl = (u.pn & 1) * 256 + wc * 64 + 8 * fq;
        if (kind == 2 || kind == 6) {
            bf16_t* VT = (kind == 2) ? SBVT : DFVT; const int dsh = (kind == 2) ? 6 : 7;
            const int pos = 8 * ((fr >> 2) & 1) + (fr & 3) + 4 * (fr >> 3);
#pragma unroll
            for (int ai = 0; ai < 2; ++ai)
#pragma unroll
                for (int m = 0; m < 4; ++m) {
                    const int row = row0 + ai * HALF + m * 16; const int b = row >> 13, t = row & 8191; const int tb = (t & 48) + pos; const int tT = t >> 6;
#pragma unroll
                    for (int bj = 0; bj < 2; ++bj)
#pragma unroll
                        for (int n = 0; n < 2; ++n)
#pragma unroll
                            for (int e = 0; e < 4; ++e) { const int col = cl + 32 * bj + 4 * n + e; const unsigned w = cvt_pk_bf16(acc[ai][bj][m][n][e], 0.f);
                                const int hh = col >> dsh, dd = col & ((1 << dsh) - 1);
                                VT[((size_t)(b * (512 >> dsh) + hh) * 128 + tT) * (size_t)(64 << dsh) + dd * 64 + tb] = (bf16_t)(w & 0xffffu); }
                }
            return;
        }
        bf16_t* O = kind == 0 ? SBQ : kind == 1 ? SBK : kind == 3 ? SBG : kind == 4 ? DFQ : kind == 5 ? DFK : DFG;
        f32x4 gv[2][2];
        if (kind == 4 || kind == 5) { const float* g = (kind == 4) ? qg : kg;
#pragma unroll
            for (int bj = 0; bj < 2; ++bj)
#pragma unroll
                for (int n = 0; n < 2; ++n) gv[bj][n] = *(const f32x4*)(g + 32 * bj + 8 * fq + 4 * n); }
#pragma unroll
        for (int ai = 0; ai < 2; ++ai)
#pragma unroll
            for (int m = 0; m < 4; ++m) {
                const int row = row0 + ai * HALF + m * 16;
                f32x4 v[2][2];
#pragma unroll
                for (int bj = 0; bj < 2; ++bj)
#pragma unroll
                    for (int n = 0; n < 2; ++n) v[bj][n] = acc[ai][bj][m][n];
                if (kind == 4 || kind == 5) {
                    float ss = 0.f;
#pragma unroll
                    for (int bj = 0; bj < 2; ++bj)
#pragma unroll
                        for (int n = 0; n < 2; ++n) { const f32x4 x = v[bj][n]; ss += (x[0] * x[0] + x[1] * x[1]) + (x[2] * x[2] + x[3] * x[3]); }
                    ss += __shfl_xor(ss, 16); ss += __shfl_xor(ss, 32);
                    float rs = 1.0f / sqrtf(ss * (1.0f / 64.0f) + 1e-6f); if (kind == 4) rs *= 0.125f * 1.4426950408889634f;
#pragma unroll
                    for (int bj = 0; bj < 2; ++bj)
#pragma unroll
                        for (int n = 0; n < 2; ++n) v[bj][n] = v[bj][n] * rs * gv[bj][n];
                } else if (kind == 0) {
#pragma unroll
                    for (int bj = 0; bj < 2; ++bj)
#pragma unroll
                        for (int n = 0; n < 2; ++n) v[bj][n] = v[bj][n] * (0.125f * 1.4426950408889634f);
                } else if (kind == 3 || kind == 7) {
#pragma unroll
                    for (int bj = 0; bj < 2; ++bj)
#pragma unroll
                        for (int n = 0; n < 2; ++n)
#pragma unroll
                            for (int e = 0; e < 4; ++e) { const float x = v[bj][n][e]; v[bj][n][e] = x * __builtin_amdgcn_rcpf(1.0f + __builtin_amdgcn_exp2f(-1.4426950408889634f * x)); }
                }
                bf16_t* rowp = O + (size_t)row * 512 + cl;
#pragma unroll
                for (int bj = 0; bj < 2; ++bj) { u32x4 w; w.x = cvt_pk_bf16(v[bj][0][0], v[bj][0][1]); w.y = cvt_pk_bf16(v[bj][0][2], v[bj][0][3]); w.z = cvt_pk_bf16(v[bj][1][0], v[bj][1][1]); w.w = cvt_pk_bf16(v[bj][1][2], v[bj][1][3]);
                    if (kind == 1 || kind == 5) *(u32x4*)(rowp + 32 * bj) = w; else __builtin_nontemporal_store(w, (u32x4*)(rowp + 32 * bj)); }
            }
    }
};
struct EpiOut {
    static constexpr bool PERM = true, AFTER_DRAIN = false;
    const float* x; const float* mod; float* out;
    __device__ __forceinline__ void operator()(const f32x4 (&acc)[2][2][4][2], const Unit& u, int wr, int wc, int fr, int fq) const {
        const int row0 = u.pm * BM + wr * 64 + fr, col0 = u.pn * BM + wc * 32 + 8 * fq; const int b = u.pm >> 5;
#pragma unroll
        for (int bj = 0; bj < 2; ++bj) { const int col = col0 + bj * HALF; const f32x4 g0 = *(const f32x4*)(mod + b * 3072 + 2048 + col), g1 = *(const f32x4*)(mod + b * 3072 + 2048 + col + 4);
#pragma unroll
            for (int ai = 0; ai < 2; ++ai)
#pragma unroll
                for (int m = 0; m < 4; ++m) { const size_t off = (size_t)(row0 + ai * HALF + m * 16) * 1024 + col; const f32x4 x0 = __builtin_nontemporal_load((const f32x4*)(x + off)), x1 = __builtin_nontemporal_load((const f32x4*)(x + off + 4));
                    *(f32x4*)(out + off) = x0 + g0 * acc[ai][bj][m][0]; *(f32x4*)(out + off + 4) = x1 + g1 * acc[ai][bj][m][1]; } }
    }
};
}

namespace att {
typedef unsigned short bf16_t;
typedef short bf16x8 __attribute__((ext_vector_type(8)));
typedef float f32x16 __attribute__((ext_vector_type(16)));
typedef float f32x4 __attribute__((ext_vector_type(4)));
typedef float f32x2 __attribute__((ext_vector_type(2)));
typedef __bf16 bf16x2 __attribute__((ext_vector_type(2)));
typedef unsigned u32x4 __attribute__((ext_vector_type(4)));
typedef unsigned u32x2 __attribute__((ext_vector_type(2)));
#define MFMA32(a, b, c) __builtin_amdgcn_mfma_f32_32x32x16_bf16((a), (b), (c), 0, 0, 0)
#define DI __device__ __forceinline__
#define FENCE() do { asm volatile("" ::: "memory"); __builtin_amdgcn_sched_barrier(0); } while (0)
DI unsigned cvtpk(float lo, float hi) { f32x2 v = {lo, hi}; bf16x2 b = __builtin_convertvector(v, bf16x2); return __builtin_bit_cast(unsigned, b); }
DI float bf_lo(unsigned w) { return __uint_as_float(w << 16); }
DI float bf_hi(unsigned w) { return __uint_as_float(w & 0xffff0000u); }
DI int crow(int r, int hi) { return (r & 3) + 8 * (r >> 2) + 4 * hi; }
DI float ex2(float x) { return __builtin_amdgcn_exp2f(x); }
DI float lg2(float x) { return __builtin_amdgcn_logf(x); }
template <int S> DI bf16x8 pack8(const f32x16& x) { u32x4 p; p[0] = cvtpk(x[8 * S], x[8 * S + 1]); p[1] = cvtpk(x[8 * S + 2], x[8 * S + 3]); p[2] = cvtpk(x[8 * S + 4], x[8 * S + 5]); p[3] = cvtpk(x[8 * S + 6], x[8 * S + 7]); return __builtin_bit_cast(bf16x8, p); }
template <int S> DI void pack8_hl(const f32x16& x, bf16x8& h, bf16x8& l) { u32x4 p, q;
#pragma unroll
    for (int i = 0; i < 4; ++i) { const float a = x[8 * S + 2 * i], b = x[8 * S + 2 * i + 1]; const unsigned w = cvtpk(a, b); p[i] = w; q[i] = cvtpk(a - bf_lo(w), b - bf_hi(w)); }
    h = __builtin_bit_cast(bf16x8, p); l = __builtin_bit_cast(bf16x8, q); }
DI int off128(int row, int c) { return row * 128 + ((c ^ ((row >> 1) & 7)) << 4); }
DI int off256(int row, int c) { return row * 256 + ((c ^ (row & 15)) << 4); }
DI bf16x8 ldsv(const LAS char* p) { return *(const LAS bf16x8*)p; }
DI f32x16 splat16(float v) { f32x16 r;
#pragma unroll
    for (int i = 0; i < 16; ++i) r[i] = v;
    return r; }

DI void swz_in(u32x4 t, u32x2& g0, u32x2& g1) { auto r0 = __builtin_amdgcn_permlane32_swap(t.x, t.z, false, false); auto r1 = __builtin_amdgcn_permlane32_swap(t.y, t.w, false, false); g0.x = r0[0]; g0.y = r1[0]; g1.x = r0[1]; g1.y = r1[1]; }
DI u32x4 swz_out(u32x2 w0, u32x2 w1) { auto r0 = __builtin_amdgcn_permlane32_swap(w0.x, w1.x, false, false); auto r1 = __builtin_amdgcn_permlane32_swap(w0.y, w1.y, false, false); u32x4 o; o.x = r0[0]; o.y = r1[0]; o.z = r0[1]; o.w = r1[1]; return o; }
DI void glds16(const void* gsrc, unsigned lds_dst) { unsigned keep;
    asm volatile("s_mov_b32 %0, m0\n\ts_mov_b32 m0, %2\n\ts_nop 0\n\tglobal_load_lds_dwordx4 %1, off\n\ts_mov_b32 m0, %0" : "=&s"(keep) : "v"(gsrc), "s"(lds_dst) : "memory"); }
#define WAIT_BAR0() asm volatile("s_waitcnt vmcnt(0) lgkmcnt(0)\n\ts_barrier" ::: "memory")
#define WAIT_BAR1() asm volatile("s_waitcnt vmcnt(1) lgkmcnt(0)\n\ts_barrier" ::: "memory")
#define WAIT_BAR4() asm volatile("s_waitcnt vmcnt(4) lgkmcnt(0)\n\ts_barrier" ::: "memory")
#define RFL(x) ((unsigned)__builtin_amdgcn_readfirstlane((int)(x)))

DI void sb_unit(LAS char* lds, int b, int h, int qb, const bf16_t* __restrict__ Q, const bf16_t* __restrict__ K, const bf16_t* __restrict__ VT, const bf16_t* __restrict__ G, bf16_t* __restrict__ MIX) {
    int tid_ = threadIdx.x; asm volatile("" : "+v"(tid_));
    const int tid = tid_, lane = tid & 63, r32 = lane & 31, hi = lane >> 5; const int wid = __builtin_amdgcn_readfirstlane(tid >> 6);
    const int q0 = qb * 256, qw0 = q0 + 32 * wid, tq = qw0 + r32;
    volatile LAS int* flags = (volatile LAS int*)(lds + MISC_OFF);
    const unsigned lds0 = (unsigned)(uintptr_t)lds;
    bf16x8 qf[4];
#pragma unroll
    for (int d0 = 0; d0 < 4; ++d0) qf[d0] = __builtin_nontemporal_load((const bf16x8*)(Q + (size_t)(b * SEQ + tq) * 512 + h * 64 + d0 * 16 + hi * 8));
    bf16x8 tp0, tp1, ones;
#pragma unroll
    for (int j = 0; j < 8; ++j) { const int kvk = 8 * (j >> 2) + 4 * hi + (j & 3); tp0[j] = (kvk > r32) ? (short)0x3F80 : (short)0; tp1[j] = (16 + kvk > r32) ? (short)0x3F80 : (short)0; ones[j] = (short)0x3F80; }
    const int drow = 8 * wid + (lane >> 3), dch = (lane & 7) ^ ((drow >> 1) & 7);
    const bf16_t* ksrc = K + (size_t)(b * SEQ + drow) * 512 + h * 64 + dch * 8;
    const bf16_t* vsrc = VT + (size_t)(b * 8 + h) * (SEQ * 64) + drow * 64 + dch * 8;
#define SB_DMA(T, st) do { const unsigned base_ = lds0 + (st) * 16384 + wid * 1024; glds16(ksrc + (size_t)(T) * 64 * 512, RFL(base_)); glds16(vsrc + (size_t)(T) * 4096, RFL(base_ + 8192)); } while (0)
    f32x16 o0 = splat16(0.f), o1 = splat16(0.f); float carry = 0.f; int done = 0;
    const int nt = (q0 + 256) / 64;
    WAIT_BAR0();
    SB_DMA(nt - 1, 0);
    for (int T = nt - 1, it = 0; T >= 0; --T, ++it) {
        WAIT_BAR0();
        if (it > 0) { volatile LAS int* fl = flags + ((it & 1) ^ 1) * 8; const int all = fl[0] & fl[1] & fl[2] & fl[3] & fl[4] & fl[5] & fl[6] & fl[7]; if (all) break; }
        if (T > 0) SB_DMA(T - 1, (it + 1) & 1);
        const LAS char* Kt = lds + (it & 1) * 16384; const LAS char* Vt = Kt + 8192;
        const int kv0 = 64 * T;
        if (kv0 < qw0 + 31 && !done) {
            f32x16 p0 = splat16(0.f), p1 = splat16(0.f);
#pragma unroll
            for (int d0 = 0; d0 < 4; ++d0) { const bf16x8 k0 = ldsv(Kt + off128(r32, 2 * d0 + hi)), k1 = ldsv(Kt + off128(32 + r32, 2 * d0 + hi)); p0 = MFMA32(k0, qf[d0], p0); p1 = MFMA32(k1, qf[d0], p1); }
            const bool diag = (kv0 + 63 >= qw0);
            f32x16 L0, L1;
#pragma unroll
            for (int r = 0; r < 16; ++r) {
                { const float z = p0[r]; const float lg = (z > 30.f) ? z : lg2(1.0f + ex2(z)); const bool valid = !diag || (kv0 + crow(r, hi) < tq); L0[r] = valid ? -lg : 0.f; p0[r] = valid ? (z - lg) : -1e30f; }
                { const float z = p1[r]; const float lg = (z > 30.f) ? z : lg2(1.0f + ex2(z)); const bool valid = !diag || (kv0 + 32 + crow(r, hi) < tq); L1[r] = valid ? -lg : 0.f; p1[r] = valid ? (z - lg) : -1e30f; }
            }
            const bf16x8 Lh0 = pack8<0>(L0), Lh1 = pack8<1>(L0), Lh2 = pack8<0>(L1), Lh3 = pack8<1>(L1);
            f32x16 C0 = splat16(carry), C1 = C0;
            C0 = MFMA32(tp0, Lh0, C0); C0 = MFMA32(tp1, Lh1, C0); C0 = MFMA32(ones, Lh2, C0); C0 = MFMA32(ones, Lh3, C0);
            C1 = MFMA32(tp0, Lh2, C1); C1 = MFMA32(tp1, Lh3, C1);
            const float cn = C0[0] + L0[0];
            carry = __shfl(cn, r32, 64);
#pragma unroll
            for (int r = 0; r < 16; ++r) { p0[r] = ex2(p0[r] + C0[r]); p1[r] = ex2(p1[r] + C1[r]); }
            const bf16x8 pa0 = pack8<0>(p0), pa1 = pack8<1>(p0), pa2 = pack8<0>(p1), pa3 = pack8<1>(p1);
#define SB_PV(ks, pa) { const bf16x8 v0 = ldsv(Vt + off128(r32, 2 * (ks) + hi)), v1 = ldsv(Vt + off128(32 + r32, 2 * (ks) + hi)); o0 = MFMA32(v0, pa, o0); o1 = MFMA32(v1, pa, o1); }
            SB_PV(0, pa0) SB_PV(1, pa1) SB_PV(2, pa2) SB_PV(3, pa3)
#undef SB_PV
            done = __all(carry < -152.f) ? 1 : 0;
        }
        if (lane == 0) flags[(it & 1) * 8 + wid] = done;
    }
#undef SB_DMA
    const size_t trow = (size_t)(b * SEQ + tq);
#pragma unroll
    for (int db = 0; db < 2; ++db)
#pragma unroll
        for (int gp = 0; gp < 2; ++gp) { const int dc = 32 * db + 16 * gp + 8 * hi; const f32x16& o = db ? o1 : o0;
            u32x2 g0, g1; swz_in(__builtin_nontemporal_load((const u32x4*)(G + trow * 512 + h * 64 + dc)), g0, g1);
            u32x2 w0, w1; const int r0 = 8 * gp, r1 = 8 * gp + 4;
            w0.x = cvtpk(o[r0] * bf_lo(g0.x), o[r0 + 1] * bf_hi(g0.x)); w0.y = cvtpk(o[r0 + 2] * bf_lo(g0.y), o[r0 + 3] * bf_hi(g0.y));
            w1.x = cvtpk(o[r1] * bf_lo(g1.x), o[r1 + 1] * bf_hi(g1.x)); w1.y = cvtpk(o[r1 + 2] * bf_lo(g1.y), o[r1 + 3] * bf_hi(g1.y));
            *(u32x4*)(MIX + trow * 1024 + h * 64 + dc) = swz_out(w0, w1); }
}

struct DfCtx { int kad[4], vad[4]; bf16x8 qf[4]; float c0, sl; int tq, qw0, hi; };
#define PIN4(x) asm volatile("" : "+v"(x[0]), "+v"(x[1]), "+v"(x[2]), "+v"(x[3]))
#define MEMFENCE() asm volatile("" ::: "memory")
DI void df_scores(const LAS char* Kst, const DfCtx& c, f32x16& p, f32x16& q, int kv0) {
    const float bb = c.c0 + c.sl * (float)kv0;
    bf16x8 k0[4], k1[4];
#pragma unroll
    for (int d0 = 0; d0 < 4; ++d0) k0[d0] = ldsv(Kst + c.kad[d0]);
    MEMFENCE();
#pragma unroll
    for (int r = 0; r < 16; ++r) p[r] = __builtin_fmaf(c.sl, (float)((r & 3) + 8 * (r >> 2)), bb);
    PIN4(k0);
#pragma unroll
    for (int d0 = 0; d0 < 4; ++d0) p = MFMA32(k0[d0], c.qf[d0], p);
#pragma unroll
    for (int d0 = 0; d0 < 4; ++d0) k1[d0] = ldsv(Kst + c.kad[d0] + 8192);
    MEMFENCE();
    { const float ba = bb + c.sl * 32.0f;
#pragma unroll
      for (int r = 0; r < 16; ++r) q[r] = __builtin_fmaf(c.sl, (float)((r & 3) + 8 * (r >> 2)), ba); }
    PIN4(k1);
#pragma unroll
    for (int d0 = 0; d0 < 4; ++d0) q = MFMA32(k1[d0], c.qf[d0], q);
}
template <bool PV> DI void df_pv_exp(const LAS char* Vst, const DfCtx& c, const bf16x8 (&pw)[4], f32x16 (&O)[4], f32x16& p, f32x16& q, bf16x8 (&pwN)[4], float& l, bool dg, int kv0) {
    bf16x8 v0[4];
    if (PV) {
#pragma unroll
        for (int ks = 0; ks < 4; ++ks) v0[ks] = ldsv(Vst + c.vad[ks]);
        MEMFENCE(); }
#pragma unroll
    for (int r = 0; r < 16; ++r) p[r] = ex2(p[r]);
    if (PV) {
        PIN4(v0);
#pragma unroll
        for (int ks = 0; ks < 4; ++ks) O[0] = MFMA32(v0[ks], pw[ks], O[0]);
#pragma unroll
        for (int ks = 0; ks < 4; ++ks) v0[ks] = ldsv(Vst + c.vad[ks] + 4096);
        MEMFENCE(); }
#pragma unroll
    for (int r = 0; r < 16; ++r) q[r] = ex2(q[r]);
    if (PV) {
        PIN4(v0);
#pragma unroll
        for (int ks = 0; ks < 4; ++ks) O[1] = MFMA32(v0[ks], pw[ks], O[1]);
#pragma unroll
        for (int ks = 0; ks < 4; ++ks) v0[ks] = ldsv(Vst + c.vad[ks] + 8192);
        MEMFENCE(); }
    if (dg) { const int lim = c.tq - kv0 - 4 * c.hi;
#pragma unroll
        for (int r = 0; r < 16; ++r) { if ((r & 3) + 8 * (r >> 2) > lim) p[r] = 0.f; if (32 + (r & 3) + 8 * (r >> 2) > lim) q[r] = 0.f; } }
    float ls = 0.f;
#pragma unroll
    for (int r = 0; r < 16; ++r) ls += p[r] + q[r];
    l += ls;
    if (PV) {
        PIN4(v0);
#pragma unroll
        for (int ks = 0; ks < 4; ++ks) O[2] = MFMA32(v0[ks], pw[ks], O[2]);
#pragma unroll
        for (int ks = 0; ks < 4; ++ks) v0[ks] = ldsv(Vst + c.vad[ks] + 12288);
        MEMFENCE(); }
    pwN[0] = pack8<0>(p); pwN[1] = pack8<1>(p); pwN[2] = pack8<0>(q); pwN[3] = pack8<1>(q);
    if (PV) {
        PIN4(v0);
#pragma unroll
        for (int ks = 0; ks < 4; ++ks) O[3] = MFMA32(v0[ks], pw[ks], O[3]);
    }
}
constexpr int DF_KR = 0, DF_VR = 65536;
DI void df_unit(LAS char* lds, int b, int h, int qb, const bf16_t* __restrict__ Q, const bf16_t* __restrict__ K, const bf16_t* __restrict__ VT, const bf16_t* __restrict__ G, bf16_t* __restrict__ MIX,
                float lam, float Mb  , const float* __restrict__ subg) {
    int tid_ = threadIdx.x; asm volatile("" : "+v"(tid_));
    const int tid = tid_, lane = tid & 63, r32 = lane & 31, hi = lane >> 5; const int wid = __builtin_amdgcn_readfirstlane(tid >> 6);
    const int mp = wid >> 2, wq = wid & 3;
    const int q0 = qb * 128, qw0 = q0 + 32 * wq, tq = qw0 + r32;
    LAS float* Xch = (LAS float*)lds;
    const unsigned lds0 = (unsigned)(uintptr_t)lds;
    DfCtx c; c.qw0 = qw0; c.tq = 0; c.hi = 0;
#pragma unroll
    for (int d0 = 0; d0 < 4; ++d0) c.qf[d0] = __builtin_nontemporal_load((const bf16x8*)(Q + (size_t)(b * SEQ + tq) * 512 + h * 128 + mp * 64 + d0 * 16 + hi * 8));
    { const int kx = hi ^ (r32 & 15), vx = hi ^ ((r32 >> 1) & 7);
#pragma unroll
      for (int i = 0; i < 4; ++i) { c.kad[i] = r32 * 256 + (((8 * mp + 2 * i) ^ kx) << 4); c.vad[i] = r32 * 128 + (((2 * i) ^ vx) << 4); } }
    const int krow = 4 * wid + (lane >> 4), kch = (lane & 15) ^ (krow & 15);
    const int vrow = 8 * wid + (lane >> 3), vch = (lane & 7) ^ ((vrow >> 1) & 7);
    const bf16_t* ksrc = K + (size_t)(b * SEQ + krow) * 512 + h * 128 + kch * 8;
    const bf16_t* vsrc = VT + (size_t)(b * 4 + h) * (SEQ * 128) + vrow * 64 + vch * 8;
#define DF_DMA(T, ko_, vo_) do { const unsigned kb_ = lds0 + DF_KR + (ko_) + wid * 1024, vb_ = lds0 + DF_VR + (vo_) + wid * 1024; const bf16_t* kp_ = ksrc + (size_t)(T) * 64 * 512; const bf16_t* vp_ = vsrc + (size_t)(T) * 8192; \
        glds16(kp_, RFL(kb_)); glds16(kp_ + 32 * 512, RFL(kb_ + 8192)); glds16(vp_, RFL(vb_)); glds16(vp_ + 4096, RFL(vb_ + 8192)); } while (0)
    f32x16 O[4];
#pragma unroll
    for (int i = 0; i < 4; ++i) O[i] = splat16(0.f);
    float l = 0.f;
    const float slope2 = ex2(-2.0f * (float)(h + 1)) * LOG2E;
    c.sl = slope2; c.c0 = -slope2 * (float)(tq - 4 * hi) - Mb;
    const int nt = (q0 + 128) / 64;
    int T0 = 0; { float mb2 = Mb; asm volatile("" : "+s"(mb2)); const int W = (int)ceilf((150.0f + 2.0f * mb2) / slope2) + 1; const int x = q0 - 63 - W; if (x >= 0) T0 = x / 64 + 1; }
    WAIT_BAR0();
    DF_DMA(T0, 0, 0); if (T0 + 1 < nt) DF_DMA(T0 + 1, 16384, 16384);
    bf16x8 pw[4], pwN[4]; f32x16 p, q;
#define DF_HEAD(so_, T) do { if ((T) + 1 < nt) WAIT_BAR4(); else WAIT_BAR0(); if ((T) + 2 < nt) DF_DMA((T) + 2, ((so_) + 32768) & 65535, ((so_) + 32768) & 65535); } while (0)
#define DF_ROT() do { _Pragma("unroll") for (int i = 0; i < 4; ++i) pw[i] = pwN[i]; } while (0)
    c.tq = tq; c.hi = hi;
    DF_HEAD(0, T0); df_scores(lds + DF_KR, c, p, q, 64 * T0); df_pv_exp<false>(lds + DF_VR, c, pw, O, p, q, pwN, l, T0 >= nt - 2, 64 * T0); DF_ROT();
    bool havep = true;
#define DF_MAIN(so_, T) do { DF_HEAD(so_, T); df_scores(lds + DF_KR + (so_), c, p, q, 64 * (T)); df_pv_exp<true>(lds + DF_VR + (((so_) + 49152) & 65535), c, pw, O, p, q, pwN, l, false, 64 * (T)); DF_ROT(); } while (0)
    int T = T0 + 1;
    for (; T + 4 <= nt - 2; T += 4) { DF_MAIN(16384, T); DF_MAIN(32768, T + 1); DF_MAIN(49152, T + 2); DF_MAIN(0, T + 3); }
    int so = 16384;
    { int tt_ = threadIdx.x; asm volatile("" : "+v"(tt_)); c.tq = q0 + 32 * wq + (tt_ & 31); c.hi = (tt_ & 63) >> 5; }
#pragma unroll 1
    for (; T < nt; ++T) {
        DF_HEAD(so, T);
        const bool dg = T >= nt - 2; const int kv0 = 64 * T; const int vpo = (so + 49152) & 65535;
        if (!(dg && kv0 > qw0 + 31)) { df_scores(lds + DF_KR + so, c, p, q, kv0); df_pv_exp<true>(lds + DF_VR + vpo, c, pw, O, p, q, pwN, l, dg, kv0); DF_ROT(); }
        else { if (havep) {
#pragma unroll
                for (int db = 0; db < 4; ++db)
#pragma unroll
                    for (int ks = 0; ks < 4; ++ks) O[db] = MFMA32(ldsv(lds + DF_VR + vpo + c.vad[ks] + db * 4096), pw[ks], O[db]); }
               havep = false; }
        so = (so + 16384) & 65535;
    }
    const int vprev = ((nt - 1 - T0) & 3) * 16384;
#undef DF_HEAD
#undef DF_ROT
#undef DF_MAIN
    if (havep) {
#pragma unroll
        for (int db = 0; db < 4; ++db)
#pragma unroll
            for (int ks = 0; ks < 4; ++ks) O[db] = MFMA32(ldsv(lds + DF_VR + vprev + c.vad[ks] + db * 4096), pw[ks], O[db]); }
#undef DF_DMA
    int te_ = threadIdx.x; asm volatile("" : "+v"(te_));
    const int lane2 = te_ & 63, hi2 = lane2 >> 5, tq2 = q0 + 32 * wq + (lane2 & 31);
    l += __shfl_xor(l, 32);
    WAIT_BAR0();
    if (mp == 1) { const float i2 = lam / l;
#pragma unroll
        for (int db = 0; db < 4; ++db)
#pragma unroll
            for (int r = 0; r < 16; ++r) Xch[(wq * 64 + db * 16 + r) * 64 + lane2] = O[db][r] * i2; }
    WAIT_BAR0();
    if (mp == 0) {
        const float i1 = 1.0f / l; float ss = 0.f;
#pragma unroll
        for (int db = 0; db < 4; ++db)
            {
#pragma unroll
              for (int r = 0; r < 16; ++r) { const float v = O[db][r] * i1 - Xch[(wq * 64 + db * 16 + r) * 64 + lane2]; O[db][r] = v; ss += v * v; } asm volatile("" : "+v"(O[db]), "+v"(ss) :: "memory"); }
        ss += __shfl_xor(ss, 32);
        const float rs = 0.8f / sqrtf(ss * (1.0f / 128.0f) + EPS);
        const size_t trow = (size_t)(b * SEQ + tq2);
#pragma unroll
        for (int db = 0; db < 4; ++db)
#pragma unroll
            for (int gp = 0; gp < 2; ++gp) { const int dc = 32 * db + 16 * gp + 8 * hi2, d0 = 32 * db + 16 * gp + 4 * hi2, d1 = d0 + 8; const int r0 = 8 * gp, r1 = 8 * gp + 4;
                u32x2 g0, g1; swz_in(__builtin_nontemporal_load((const u32x4*)(G + trow * 512 + h * 128 + dc)), g0, g1);
                const f32x4 s0 = *(const f32x4*)(subg + d0), s1 = *(const f32x4*)(subg + d1);
                u32x2 w0, w1;
                w0.x = cvtpk(O[db][r0] * rs * s0[0] * bf_lo(g0.x), O[db][r0 + 1] * rs * s0[1] * bf_hi(g0.x)); w0.y = cvtpk(O[db][r0 + 2] * rs * s0[2] * bf_lo(g0.y), O[db][r0 + 3] * rs * s0[3] * bf_hi(g0.y));
                w1.x = cvtpk(O[db][r1] * rs * s1[0] * bf_lo(g1.x), O[db][r1 + 1] * rs * s1[1] * bf_hi(g1.x)); w1.y = cvtpk(O[db][r1 + 2] * rs * s1[2] * bf_lo(g1.y), O[db][r1 + 3] * rs * s1[3] * bf_hi(g1.y));
                *(u32x4*)(MIX + trow * 1024 + 512 + h * 128 + dc) = swz_out(w0, w1); asm volatile("" ::: "memory"); }
    }
}
}

typedef unsigned short bf16;
typedef unsigned v4u __attribute__((ext_vector_type(4)));
typedef float f32x4 __attribute__((ext_vector_type(4)));
__device__ __forceinline__ unsigned f2bf(float f) { unsigned u = __builtin_bit_cast(unsigned, f); return (u + 0x7fffu + ((u >> 16) & 1u)) >> 16; }
__device__ __forceinline__ unsigned pk2(float lo, float hi) { return f2bf(lo) | (f2bf(hi) << 16); }
__device__ __forceinline__ float wave_sum(float v) {
#pragma unroll
    for (int o = 1; o < 64; o <<= 1) v += __shfl_xor(v, o);
    return v; }
__device__ __forceinline__ float wave_max(float v) {
#pragma unroll
    for (int o = 1; o < 64; o <<= 1) v = fmaxf(v, __shfl_xor(v, o));
    return v; }
template <bool PERMROWS> __device__ __forceinline__ void transpose_item(const float* W, int K, int N, bf16* WT, LAS float* scr, int item, int lane) {
    const int nblk = N / 32, kb = item / nblk, nb = item % nblk, k0 = 64 * kb, n0 = 32 * nb;
    float tv[32];
#pragma unroll
    for (int i = 0; i < 32; ++i) tv[i] = __builtin_nontemporal_load(W + (size_t)(k0 + 2 * i + (lane >> 5)) * N + n0 + (lane & 31));
#pragma unroll
    for (int i = 0; i < 32; ++i) scr[(2 * i + (lane >> 5)) * 33 + (lane & 31)] = tv[i];
    asm volatile("s_waitcnt lgkmcnt(0)" ::: "memory");
    int r0 = n0;
    if (PERMROWS) { const int L0 = n0 & 255; r0 = (n0 & ~255) + 128 * ((L0 >> 5) & 1) + 32 * (L0 >> 6); }
    const int c = lane & 7;
#pragma unroll
    for (int j = 0; j < 4; ++j) { const int n = (lane >> 3) + 8 * j; const LAS float* s = scr + (8 * c) * 33 + n;
        v4u o; o.x = pk2(s[0 * 33], s[1 * 33]); o.y = pk2(s[2 * 33], s[3 * 33]); o.z = pk2(s[4 * 33], s[5 * 33]); o.w = pk2(s[6 * 33], s[7 * 33]);
        *(v4u*)(WT + (size_t)(r0 + n) * K + k0 + 8 * c) = o; }
    asm volatile("s_waitcnt lgkmcnt(0)" ::: "memory");
}

#define XB_TMO      128
#define XB_XCNT(j)  (256  + 64 * (j))
#define XB_XSUB(j)  (1280 + 64 * (j))
#define XB_XGEN(j)  (2304 + 64 * (j))
#define XB_TOP      3328
#define XB_TOPGEN   3392
#define XCD_BAR_WORDS 3456
#define XB_SPIN_CAP (1u << 18)

__device__ __forceinline__ unsigned xb_ld(unsigned* p)              { return __hip_atomic_load(p, __ATOMIC_RELAXED, __HIP_MEMORY_SCOPE_AGENT); }
__device__ __forceinline__ unsigned xb_add(unsigned* p, unsigned v) { return __hip_atomic_fetch_add(p, v, __ATOMIC_RELAXED, __HIP_MEMORY_SCOPE_AGENT); }
__device__ __forceinline__ unsigned xb_xcc_id() { return (unsigned)__builtin_amdgcn_s_getreg((3 << 11) | 20) & 0xFu; }
#define XB_SPIN(cond, bar) do { unsigned _sp = 0; while (cond) { __builtin_amdgcn_s_sleep(1); \
    if ((++_sp & 255u) == 0u) { if (xb_ld(&(bar)[XB_TMO])) break; if (_sp > XB_SPIN_CAP) { atomicAdd(&(bar)[XB_TMO], 1u); break; } } } } while (0)

struct XcdBarrier {
    unsigned* bar; unsigned x;
    volatile LAS unsigned* st;
};

__device__ __forceinline__ XcdBarrier xcd_barrier_post(unsigned* bar, volatile LAS unsigned* st) {
    XcdBarrier b; b.bar = bar; b.x = xb_xcc_id(); b.st = st;
    if (threadIdx.x == 0) (void)xb_add(&bar[XB_XCNT(b.x)], 1u);
    return b;
}
__device__ __forceinline__ void xcd_barrier_complete(unsigned* bar, unsigned x, unsigned& nloc, unsigned& nx) {
    const unsigned G = gridDim.x * gridDim.y * gridDim.z;
    unsigned sum, cnt, mine, sp = 0u;
    for (;;) {
        sum = 0u; cnt = 0u; mine = 0u;
#pragma unroll
        for (unsigned j = 0; j < 16; ++j) { const unsigned c = xb_ld(&bar[XB_XCNT(j)]); sum += c; cnt += (c > 0u) ? 1u : 0u; mine = (j == x) ? c : mine; }
        if (sum == G) break;
        __builtin_amdgcn_s_sleep(1);
        if ((++sp & 255u) == 0u) { if (xb_ld(&bar[XB_TMO])) break; if (sp > XB_SPIN_CAP) { atomicAdd(&bar[XB_TMO], 1u); break; } }
    }
    nloc = mine > 0u ? mine : 1u; nx = cnt > 0u ? cnt : 1u;
}

__device__ __forceinline__ void xcd_barrier(const XcdBarrier& b) {
    asm volatile("s_waitcnt vmcnt(0)" ::: "memory");
    __syncthreads();
    if (threadIdx.x == 0) {
        unsigned* bar = b.bar;
        __builtin_amdgcn_s_waitcnt(0);
        unsigned nloc = b.st[0], nx = b.st[1];
        if (nloc == 0u) { xcd_barrier_complete(bar, b.x, nloc, nx); b.st[0] = nloc; b.st[1] = nx; }
        const unsigned old = xb_add(&bar[XB_XSUB(b.x)], 1u);
        const unsigned gen = old / nloc;
        if (old + 1u == (gen + 1u) * nloc) {
            __builtin_amdgcn_fence(__ATOMIC_RELEASE, "agent");
            asm volatile("s_waitcnt vmcnt(0)" ::: "memory");
            const unsigned og = xb_add(&bar[XB_TOP], 1u);
            const unsigned tg = og / nx;
            if (og + 1u == (tg + 1u) * nx) xb_add(&bar[XB_TOPGEN], 1u);
            else XB_SPIN(xb_ld(&bar[XB_TOPGEN]) == tg, bar);
            __builtin_amdgcn_fence(__ATOMIC_ACQUIRE, "agent");
            xb_add(&bar[XB_XGEN(b.x)], 1u);
            asm volatile("s_waitcnt vmcnt(0)" ::: "memory");
        } else {
            XB_SPIN(xb_ld(&bar[XB_XGEN(b.x)]) == gen, bar);
            __builtin_amdgcn_fence(__ATOMIC_ACQUIRE, "agent");
            asm volatile("s_waitcnt vmcnt(0)" ::: "memory");
        }
    }
    __syncthreads();
}

struct Args { const float *x, *c, *norm_g, *w_ada, *b_ada, *w_in, *qg, *kg, *lq1, *lk1, *lq2, *lk2, *subg, *w_out; float* out; unsigned char* ws; };

__global__ void __launch_bounds__(512) fwd_megakernel(Args a) {
    extern __shared__ __attribute__((aligned(16))) unsigned char lds_raw[];
    cg::grid_group grid = cg::this_grid();
    LAS unsigned char* lds = (LAS unsigned char*)lds_raw;
    const int tid = threadIdx.x, lane = tid & 63; const int wid = __builtin_amdgcn_readfirstlane(tid >> 6);
    const int blk = blockIdx.x, G = gridDim.x;
    unsigned char* ws = a.ws;
    float* mod = (float*)(ws + WS_MOD);
    unsigned* barw = (unsigned*)(ws + WS_BAR);
    volatile LAS unsigned* bst = (volatile LAS unsigned*)(lds + LDSCTL_OFF);
    if (tid < 16) bst[tid] = 0u;
    __syncthreads();
    XcdBarrier bar = xcd_barrier_post(barw, bst);
    if (a.ws == nullptr) grid.sync();
    bf16* WinT = (bf16*)(ws + WS_WIN); bf16* WoutT = (bf16*)(ws + WS_WOUT); bf16* XN = (bf16*)(ws + WS_XN);
    bf16* SBQ = (bf16*)(ws + WS_SBQ); bf16* SBK = (bf16*)(ws + WS_SBK); bf16* SBG = (bf16*)(ws + WS_SBG);
    bf16* DFQ = (bf16*)(ws + WS_DFQ); bf16* DFK = (bf16*)(ws + WS_DFK); bf16* DFG = (bf16*)(ws + WS_DFG);
    bf16* SBVT = (bf16*)(ws + WS_SBVT); bf16* DFVT = (bf16*)(ws + WS_DFVT); bf16* MIX = (bf16*)(ws + WS_MIX);

#ifndef PHM
#define PHM 31
#endif
#ifndef REP_P01
#define REP_P01 1
#endif
    for (int rep01 = 0; rep01 < REP_P01; ++rep01) {
#if PHM & 1
    if (blk < 192) {
        const int c0 = 16 * blk, cq = tid & 3, kq = tid >> 2;
        f32x4 a0 = {0.f, 0.f, 0.f, 0.f}, a1 = a0;
#pragma unroll
        for (int i = 0; i < 8; ++i) { const int k = kq + 128 * i; const f32x4 w = __builtin_nontemporal_load((const f32x4*)(a.w_ada + (size_t)k * 3072 + c0 + 4 * cq)); a0 += a.c[k] * w; a1 += a.c[1024 + k] * w; }
#pragma unroll
        for (int o = 4; o < 64; o <<= 1)
#pragma unroll
            for (int e = 0; e < 4; ++e) { a0[e] += __shfl_xor(a0[e], o); a1[e] += __shfl_xor(a1[e], o); }
        LAS float* red = (LAS float*)(lds + MISC_OFF);
        if (lane < 4) {
#pragma unroll
            for (int e = 0; e < 4; ++e) { red[wid * 32 + lane * 4 + e] = a0[e]; red[wid * 32 + 16 + lane * 4 + e] = a1[e]; } }
        __syncthreads();
        if (tid < 32) { float s = 0.f;
#pragma unroll
            for (int w = 0; w < 8; ++w) s += red[w * 32 + tid];
            const int bb = tid >> 4, j = tid & 15; mod[bb * 3072 + c0 + j] = s + a.b_ada[c0 + j]; }
    }
    if (blk == G - 1 && wid == 0) {
        const float s1 = wave_sum(a.lq1[lane] * a.lk1[lane]), s2 = wave_sum(a.lq2[lane] * a.lk2[lane]);
        const float gq = wave_max(fabsf(a.qg[lane])), gk = wave_max(fabsf(a.kg[lane]));
        if (lane == 0) { mod[SC_LAM] = expf(s1) - expf(s2) + 0.2f; mod[SC_MB] = 8.0f * gq * gk * LOG2E; }
    }
    {
        LAS float* scr = (LAS float*)(lds + wid * 16384);
        const int gw = blk * 8 + wid, NGW = G * 8;
        constexpr int I_IN = (DM / 64) * (NIN / 32), I_OUT = (DM / 64) * (DM / 32);
        for (int it = gw; it < I_IN + I_OUT; it += NGW) {
            if (it < I_IN) transpose_item<true>(a.w_in, DM, NIN, WinT, scr, it, lane);
            else transpose_item<false>(a.w_out, DM, DM, WoutT, scr, it - I_IN, lane);
        }
    }
#endif
    f32x4 xa[4][4];
    { const int gw = blk * 8 + wid, NGW = G * 8;
#pragma unroll
      for (int u = 0; u < 4; ++u) { const int m = gw + u * NGW; const float* xr = a.x + (size_t)(m < MROWS ? m : 0) * DM;
#pragma unroll
          for (int j = 0; j < 4; ++j) xa[u][j] = __builtin_nontemporal_load((const f32x4*)(xr + 4 * lane + 256 * j)); } }
    xcd_barrier(bar);
#if PHM & 1
    {
        const int gw = blk * 8 + wid, NGW = G * 8;
#define P1_ROW(m_, v_) do { const int bb = (m_) >> 13; const float* sh = mod + bb * 3072; const float* sc = sh + 1024; float ss = 0.f; \
            _Pragma("unroll") for (int j = 0; j < 4; ++j) ss += (v_[j][0] * v_[j][0] + v_[j][1] * v_[j][1]) + (v_[j][2] * v_[j][2] + v_[j][3] * v_[j][3]); \
            const float rstd = 1.0f / sqrtf(wave_sum(ss) * (1.0f / DM) + EPS); \
            _Pragma("unroll") for (int j = 0; j < 4; ++j) { const int col = 4 * lane + 256 * j; const f32x4 g = *(const f32x4*)(a.norm_g + col), s1 = *(const f32x4*)(sc + col), s0 = *(const f32x4*)(sh + col); \
                const f32x4 hv = (v_[j] * rstd * g) * (1.0f + s1) + s0; \
                *(unsigned long long*)(XN + (size_t)(m_) * DM + col) = (unsigned long long)pk2(hv[0], hv[1]) | ((unsigned long long)pk2(hv[2], hv[3]) << 32); } } while (0)
        f32x4 xb[4][4];
#pragma unroll
        for (int u = 0; u < 4; ++u) { const int m = gw + (4 + u) * NGW; const float* xr = a.x + (size_t)(m < MROWS ? m : 0) * DM;
#pragma unroll
            for (int j = 0; j < 4; ++j) xb[u][j] = __builtin_nontemporal_load((const f32x4*)(xr + 4 * lane + 256 * j)); }
        asm volatile("" ::: "memory");
#pragma unroll
        for (int u = 0; u < 4; ++u) { const int m = gw + u * NGW; if (m < MROWS) P1_ROW(m, xa[u]); }
#pragma unroll
        for (int u = 0; u < 4; ++u) { const int m = gw + (4 + u) * NGW; if (m < MROWS) P1_ROW(m, xb[u]); }
        for (int m = gw + 8 * NGW; m < MROWS; m += NGW) {
            f32x4 v[4];
#pragma unroll
            for (int j = 0; j < 4; ++j) v[j] = *(const f32x4*)(a.x + (size_t)m * DM + 4 * lane + 256 * j);
            P1_ROW(m, v); }
#undef P1_ROW
    }
#endif
    xcd_barrier(bar);
    }
#if PHM & 2
    {
        pg8::Gemm g{XN, WinT, MROWS, NIN, DM}; pg8::StaticOrder S; S.init(MROWS, NIN, G, blk);
        pg8::EpiIn E{SBQ, SBK, SBG, DFQ, DFK, DFG, SBVT, DFVT, a.qg, a.kg};
#ifndef REP_G1
#define REP_G1 1
#endif
        pg8::gemm_phase<pg8::EpiIn, pg8::StaticOrder, true, true>(lds, g, S, E);
#if REP_G1 > 1
        pg8::gemm_phase<pg8::EpiIn, pg8::StaticOrder, true, true>(lds, g, S, E);
#endif
    }
#endif
    xcd_barrier(bar);
    {
        const float lam_u = __int_as_float(__builtin_amdgcn_readfirstlane(__float_as_int(mod[SC_LAM]))), Mb_u = __int_as_float(__builtin_amdgcn_readfirstlane(__float_as_int(mod[SC_MB])));
#ifndef REP_ATT
#define REP_ATT 1
#endif
        for (int rep = 0; rep < REP_ATT; ++rep) {
        if (rep) { xcd_barrier(bar); if (blk == 0 && tid < 8) __hip_atomic_store(barw + BAR_QCTR + 64 * tid, 0u, __ATOMIC_RELAXED, __HIP_MEMORY_SCOPE_AGENT); xcd_barrier(bar); }
        int myq = (int)(bar.x & 7u), tries = 0;
        for (;;) {
            int qo_ = LDSCTL_OFF + 64; asm volatile("" : "+s"(qo_)); volatile LAS int* qslot = (volatile LAS int*)(lds + qo_);
            int tq0_ = threadIdx.x; asm volatile("" : "+v"(tq0_));
            __syncthreads();
            if (tq0_ == 0) { int slot = -1;
                while (tries < 8) { int len = (myq < 4) ? 64 : 192;
#ifdef REP2_DF_ONLY
                    if (rep) len = 64;
#endif
#ifdef REP2_SB_ONLY
                    if (rep) { if (myq < 4) len = 0; }
#endif
 const int idx = (int)atomicAdd(barw + BAR_QCTR + 64 * myq, 1u);
#ifdef REP2_SB_ONLY
                    if (rep && myq >= 4 && idx < 64) continue;
#endif
                    if (idx < len) { slot = (myq << 16) | idx; break; } myq = (myq + 1) & 7; ++tries; }
                qslot[0] = slot; }
            __syncthreads();
            const int slot = qslot[0];
            if (slot < 0) break;
            const int q = slot >> 16, idx = slot & 0xffff;
            int ub, uh, uq; bool isdf = true;
            if (q < 4) { ub = q >> 1; uh = 3 - (q & 1); uq = 63 - idx; }
            else { const int y = q - 4;
                if (idx < 64) { ub = y >> 1; uh = 1 - (y & 1); uq = 63 - idx; }
                else { const int v = idx - 64; const int bh = 4 * y + (v & 3); ub = bh >> 3; uh = bh & 7; uq = 31 - (v >> 2); isdf = false; } }
            if (isdf) att::df_unit((LAS char*)lds, ub, uh, uq, DFQ, DFK, DFVT, DFG, MIX, lam_u, Mb_u, a.subg);
            else att::sb_unit((LAS char*)lds, ub, uh, uq, SBQ, SBK, SBVT, SBG, MIX);
        }
        }
    }
    xcd_barrier(bar);
#ifdef EXTRA_SYNCS
    for (int es = 0; es < EXTRA_SYNCS; ++es) xcd_barrier(bar);
#endif
#if PHM & 16
    {
        pg8::Gemm g{MIX, WoutT, MROWS, DM, DM}; pg8::StaticOrder S; S.init(MROWS, DM, G, blk);
        pg8::EpiOut E{a.x, mod, a.out};
#ifndef REP_G2
#define REP_G2 1
#endif
        pg8::gemm_phase<pg8::EpiOut, pg8::StaticOrder, false, true>(lds, g, S, E);
#if REP_G2 > 1
        pg8::gemm_phase<pg8::EpiOut, pg8::StaticOrder, false, true>(lds, g, S, E);
#endif
    }
#endif
}

extern "C" void kernel_launch(void* const* d_in, const int* in_sizes, int n_in, void* d_out, int out_size, void* d_ws, size_t ws_size, hipStream_t stream) {
    static int grid = 0;
    if (grid == 0) {
        int dev = 0, cus = 0, per_cu = 0;
        hipGetDevice(&dev); hipDeviceGetAttribute(&cus, hipDeviceAttributeMultiprocessorCount, dev);
        hipFuncSetAttribute((const void*)fwd_megakernel, hipFuncAttributeMaxDynamicSharedMemorySize, LDS_BYTES);
        hipOccupancyMaxActiveBlocksPerMultiprocessor(&per_cu, (const void*)fwd_megakernel, 512, LDS_BYTES);
        if (per_cu < 1) per_cu = 1;
        grid = cus * per_cu; (void)hipGetLastError();
        if (n_in != 14 || ws_size < WS_END) { fprintf(stderr, "kernel_launch: unexpected inputs (n_in %d, ws %zu)\n", n_in, ws_size); }
    }
    (void)hipMemsetAsync((char*)d_ws + WS_BAR, 0, BAR_ZERO_BYTES, stream);
    Args a{};
    a.x = (const float*)d_in[0]; a.c = (const float*)d_in[1]; a.norm_g = (const float*)d_in[2]; a.w_ada = (const float*)d_in[3]; a.b_ada = (const float*)d_in[4]; a.w_in = (const float*)d_in[5];
    a.qg = (const float*)d_in[6]; a.kg = (const float*)d_in[7]; a.lq1 = (const float*)d_in[8]; a.lk1 = (const float*)d_in[9]; a.lq2 = (const float*)d_in[10]; a.lk2 = (const float*)d_in[11];
    a.subg = (const float*)d_in[12]; a.w_out = (const float*)d_in[13]; a.out = (float*)d_out; a.ws = (unsigned char*)d_ws;
    void* args[] = {&a};
    hipError_t e = hipLaunchCooperativeKernel((const void*)fwd_megakernel, dim3(grid), dim3(512), args, LDS_BYTES, stream);
    if (e != hipSuccess) fprintf(stderr, "cooperative launch failed: %s (grid %d)\n", hipGetErrorString(e), grid);
}
```
